# Optimizing an MI355X kernel written in HIP

```python
import jax, jax.numpy as jnp
from jax import lax
import numpy as np

D_MODEL = 1024
BATCH = 8
SEQ = 4096
DEPTH = 1

N_HEADS = 8
HEAD_DIM = 128
ATTN_WIDTH = N_HEADS * HEAD_DIM
ROPE_THETA = 10000.0
IDX_HEADS = 8
IDX_DIM = 64
IDX_TOPK_MAX = 256
Q_BLOCK = 32
SGU_GROUPS = 8
SGU_WIDTH = 1024
SGU_GROUP_DIM = SGU_WIDTH // SGU_GROUPS
CHUNK = 128
N_GROUPS = 4
EXPERTS_PER_GROUP = 8
N_EXPERTS = N_GROUPS * EXPERTS_PER_GROUP
TOP_K_INNER = 2
D_EXPERT = 256
NORM_EPS = 1e-6

SPLIT_SIZES = (ATTN_WIDTH, ATTN_WIDTH, ATTN_WIDTH,
               IDX_HEADS * IDX_DIM, IDX_DIM, IDX_HEADS,
               SGU_WIDTH, SGU_WIDTH,
               D_MODEL, D_MODEL)
D_IN_PROJ = sum(SPLIT_SIZES)

kernel_name = "hybrid_gmlp_dsa_hmoe_block"


def rms_norm(x, g):
    xf = x.astype(jnp.float32)
    xf = xf * lax.rsqrt(jnp.mean(xf * xf, axis=-1, keepdims=True) + NORM_EPS)
    return (xf * g.astype(jnp.float32)).astype(x.dtype)


def layer_norm(x, g):
    xf = x.astype(jnp.float32)
    mu = jnp.mean(xf, axis=-1, keepdims=True)
    var = jnp.mean(jnp.square(xf - mu), axis=-1, keepdims=True)
    return ((xf - mu) * lax.rsqrt(var + NORM_EPS) * g.astype(jnp.float32)).astype(x.dtype)


def rope(x, positions):
    d = x.shape[-1]
    inv = ROPE_THETA ** (-jnp.arange(0, d, 2, dtype=jnp.float32) / d)
    ang = positions.astype(jnp.float32)[..., None] * inv
    cos = jnp.cos(ang)[:, :, None, :]
    sin = jnp.sin(ang)[:, :, None, :]
    x1, x2 = jnp.split(x.astype(jnp.float32), 2, axis=-1)
    out = jnp.concatenate([x1 * cos - x2 * sin, x2 * cos + x1 * sin], axis=-1)
    return out.astype(x.dtype)


def split_columns(proj):
    parts, start = [], 0
    for size in SPLIT_SIZES:
        parts.append(proj[..., start:start + size])
        start += size
    return parts


def dsa_attention(q, k, v, qi, ki, wi):
    B, L = q.shape[0], q.shape[1]
    top_k = min(IDX_TOPK_MAX, L // 4)
    nb = L // Q_BLOCK

    def to_blocks(a):
        return jnp.moveaxis(a.reshape(B, nb, Q_BLOCK, *a.shape[2:]), 1, 0)

    starts = jnp.arange(nb, dtype=jnp.int32) * Q_BLOCK
    key_pos = jnp.arange(L, dtype=jnp.int32)
    gather = jax.vmap(lambda src, idx: src[idx])

    def block(args):
        qb, qib, wb, start = args
        qpos = start + jnp.arange(Q_BLOCK, dtype=jnp.int32)
        rel = jax.nn.relu(jnp.einsum('bqhd,bsd->bqhs', qib, ki))
        score = jnp.einsum('bqh,bqhs->bqs', wb, rel).astype(jnp.float32)
        causal = key_pos[None, :] <= qpos[:, None]
        score = jnp.where(causal[None], score, -jnp.inf)
        _, sel = lax.top_k(score, top_k)
        valid = sel <= qpos[None, :, None]
        kg = gather(k, sel)
        vg = gather(v, sel)
        logits = jnp.einsum('bqhd,bqkhd->bhqk', qb, kg).astype(jnp.float32) * (HEAD_DIM ** -0.5)
        logits = jnp.where(valid[:, None], logits, -jnp.inf)
        p = jax.nn.softmax(logits, axis=-1).astype(v.dtype)
        return jnp.einsum('bhqk,bqkhd->bqhd', p, vg)

    out = lax.map(block, (to_blocks(q), to_blocks(qi), to_blocks(wi), starts))
    return jnp.moveaxis(out, 0, 1).reshape(B, L, ATTN_WIDTH)


def spatial_gating(u, v, norm_g, w_s, b_s):
    B, L, _ = u.shape
    nc = L // CHUNK
    v = layer_norm(v, norm_g)
    vc = v.reshape(B, nc, CHUNK, SGU_GROUPS, SGU_GROUP_DIM)
    mask = jnp.tril(jnp.ones((CHUNK, CHUNK), dtype=bool))
    w = jnp.where(mask[None], w_s, jnp.zeros_like(w_s))
    mixed = jnp.einsum('gts,bcsgd->bctgd', w, vc) + b_s.T[None, None, :, :, None]
    return u * mixed.reshape(B, L, SGU_WIDTH)


def hier_moe(xn, w_group, b_group, w_er, b_er, w_e_in, w_e_out):
    B, L, D = xn.shape
    T = B * L
    xt = xn.reshape(T, D)
    g_logits = (xt @ w_group).astype(jnp.float32) + b_group.astype(jnp.float32)
    g_sel = jnp.argmax(g_logits, axis=-1)
    g_prob = jnp.take_along_axis(jax.nn.softmax(g_logits, axis=-1), g_sel[:, None], axis=1)
    e_logits = ((xt @ w_er).astype(jnp.float32) + b_er.astype(jnp.float32)).reshape(T, N_GROUPS, EXPERTS_PER_GROUP)
    e_in_group = jnp.take_along_axis(e_logits, g_sel[:, None, None], axis=1)[:, 0]
    top_v, top_i = lax.top_k(e_in_group, TOP_K_INNER)
    gates = g_prob * jax.nn.softmax(top_v, axis=-1)
    expert_id = (g_sel[:, None] * EXPERTS_PER_GROUP + top_i).reshape(-1)
    token_id = jnp.repeat(jnp.arange(T, dtype=jnp.int32), TOP_K_INNER)
    order = jnp.argsort(expert_id)
    tok_sorted = token_id[order]
    group_sizes = jnp.bincount(expert_id, length=N_EXPERTS).astype(jnp.int32)
    xs = xt[tok_sorted]
    hdn = lax.ragged_dot(xs, w_e_in, group_sizes)
    gate_h, up_h = jnp.split(hdn, 2, axis=-1)
    act = jax.nn.silu(gate_h) * up_h
    ys = lax.ragged_dot(act, w_e_out, group_sizes)
    ys = ys * gates.reshape(-1)[order][:, None].astype(ys.dtype)
    return jnp.zeros_like(xt).at[tok_sorted].add(ys).reshape(B, L, D)


def setup_inputs(seed: int = 0) -> dict:
    key = jax.random.key(seed)
    ks = jax.random.split(key, 20)
    f32 = jnp.float32
    nrm = lambda k, shape, scale: jax.random.normal(k, shape, f32) * scale
    x = jax.random.normal(ks[0], (BATCH, SEQ, D_MODEL), f32)
    offset = jax.random.randint(ks[1], (BATCH, 1), 0, 1024, dtype=jnp.int32)
    positions = offset + jnp.arange(SEQ, dtype=jnp.int32)[None, :]
    return {
        "x": x,
        "positions": positions,
        "norm1_g": 1.0 + nrm(ks[2], (DEPTH, D_MODEL), 0.02),
        "w_in": nrm(ks[3], (DEPTH, D_MODEL, D_IN_PROJ), D_MODEL ** -0.5),
        "sgu_norm_g": 1.0 + nrm(ks[4], (DEPTH, SGU_WIDTH), 0.02),
        "sgu_w": nrm(ks[5], (DEPTH, SGU_GROUPS, CHUNK, CHUNK), CHUNK ** -0.5),
        "sgu_b": 1.0 + nrm(ks[6], (DEPTH, SGU_GROUPS, CHUNK), 0.1),
        "w_branch_a": nrm(ks[7], (DEPTH, SGU_WIDTH, D_MODEL), SGU_WIDTH ** -0.5),
        "w_branch_b": nrm(ks[8], (DEPTH, ATTN_WIDTH, D_MODEL), ATTN_WIDTH ** -0.5),
        "w_out": nrm(ks[9], (DEPTH, D_MODEL, D_MODEL), D_MODEL ** -0.5),
        "norm2_g": 1.0 + nrm(ks[10], (DEPTH, D_MODEL), 0.02),
        "w_router_group": nrm(ks[11], (DEPTH, D_MODEL, N_GROUPS), D_MODEL ** -0.5),
        "b_router_group": nrm(ks[12], (DEPTH, N_GROUPS), 0.01),
        "w_router_expert": nrm(ks[13], (DEPTH, D_MODEL, N_EXPERTS), D_MODEL ** -0.5),
        "b_router_expert": nrm(ks[14], (DEPTH, N_EXPERTS), 0.01),
        "w_expert_in": nrm(ks[15], (DEPTH, N_EXPERTS, D_MODEL, 2 * D_EXPERT), D_MODEL ** -0.5),
        "w_expert_out": nrm(ks[16], (DEPTH, N_EXPERTS, D_EXPERT, D_MODEL), D_EXPERT ** -0.5),
        "norm_f_g": 1.0 + nrm(ks[17], (D_MODEL,), 0.02),
    }


def reference(x, positions, norm1_g, w_in, sgu_norm_g, sgu_w, sgu_b, w_branch_a, w_branch_b,
              w_out, norm2_g, w_router_group, b_router_group, w_router_expert, b_router_expert,
              w_expert_in, w_expert_out, norm_f_g):
    B, L, _ = x.shape
    h = x
    for l in range(DEPTH):
        xn = rms_norm(h, norm1_g[l])
        proj = xn @ w_in[l]
        q, k, v, qi, ki, wi, su, sv, ga, gb = split_columns(proj)
        q = rope(q.reshape(B, L, N_HEADS, HEAD_DIM), positions)
        k = rope(k.reshape(B, L, N_HEADS, HEAD_DIM), positions)
        v = v.reshape(B, L, N_HEADS, HEAD_DIM)
        qi = rope(qi.reshape(B, L, IDX_HEADS, IDX_DIM), positions)
        ki = rope(ki[:, :, None, :], positions)[:, :, 0]
        y_attn = dsa_attention(q, k, v, qi, ki, wi)
        y_sgu = spatial_gating(jax.nn.gelu(su), jax.nn.gelu(sv), sgu_norm_g[l], sgu_w[l], sgu_b[l])
        merged = (jax.nn.sigmoid(ga) * (y_sgu @ w_branch_a[l])
                  + jax.nn.sigmoid(gb) * (y_attn @ w_branch_b[l]))
        h = h + merged @ w_out[l]
        h = h + hier_moe(rms_norm(h, norm2_g[l]), w_router_group[l], b_router_group[l],
                         w_router_expert[l], b_router_expert[l], w_expert_in[l], w_expert_out[l])
    return rms_norm(h, norm_f_g)
```

```cpp
#include <hip/hip_runtime.h>
#include <cstdio>
#include <cstdint>

#define LAS __attribute__((address_space(3)))
#define GAS __attribute__((address_space(1)))
typedef unsigned short bf16_t;
typedef short bf16x8 __attribute__((ext_vector_type(8)));
typedef short s16x4 __attribute__((ext_vector_type(4)));
typedef float f32x2 __attribute__((ext_vector_type(2)));
typedef float f32x4 __attribute__((ext_vector_type(4)));
typedef float f32x16 __attribute__((ext_vector_type(16)));
typedef unsigned u32x2 __attribute__((ext_vector_type(2)));
typedef unsigned u32x4 __attribute__((ext_vector_type(4)));
typedef unsigned long long u64;

constexpr int NB = 8, SEQ = 4096, D = 1024, T = NB * SEQ;
constexpr int NH = 8, HD = 128, IH = 8, ID = 64, TOPK = 256;
constexpr int NPROJ_SRC = 7752, NPROJ = 7936;
constexpr int NEXP = 32, DEXP = 256, EPG = 8, NGRP = 4;
constexpr float EPS = 1e-6f;
constexpr int SRC_Q = 0, SRC_K = 1024, SRC_V = 2048, SRC_QI = 3072, SRC_KI = 3584, SRC_WI = 3648, SRC_SU = 3656, SRC_SV = 4680, SRC_GA = 5704, SRC_GB = 6728;

constexpr size_t MiB = 1u << 20;
constexpr size_t WS_CTL = 0, CTL_ZERO_BYTES = 1 * MiB;
constexpr size_t WS_WIN = 1 * MiB;
constexpr size_t WS_WA = 17 * MiB, WS_WB = 19 * MiB, WS_WO = 21 * MiB;
constexpr size_t WS_ROPE = 23 * MiB;
constexpr size_t WS_WI = 39 * MiB;
constexpr size_t WS_KI = 40 * MiB;
constexpr size_t WS_SVST = 44 * MiB;
constexpr size_t WS_MASK = 52 * MiB;
constexpr size_t WS_QI = 68 * MiB;
constexpr size_t WS_XN1 = 100 * MiB;
constexpr size_t WS_Q = 164 * MiB;
constexpr size_t WS_K = 228 * MiB;
constexpr size_t WS_V = 292 * MiB;
constexpr size_t WS_SU = 356 * MiB;
constexpr size_t WS_SV = 420 * MiB;
constexpr size_t WS_END = 484 * MiB, WS_TOTAL = 485 * MiB;
constexpr size_t WS_WRT = WS_END;
constexpr size_t WS_RSTD = WS_WI + 512 * 1024;
constexpr size_t WS_H1 = WS_SU;
constexpr size_t WS_GATE = WS_WI, WS_LIST = WS_KI, WS_MG = WS_XN1, WS_YM = WS_XN1, WS_XN2 = WS_K, WS_WEIN = WS_V, WS_WEOUT = WS_V + 32 * MiB, WS_ACT = WS_SV;
constexpr int CW_ECNT = 64;
constexpr int CW_BAR = 4096;

constexpr int LDS_BYTES = 160 * 1024;
constexpr int MISC_OFF = LDS_BYTES - 256;

__device__ __forceinline__ unsigned f2bf(float f) { unsigned u = __builtin_bit_cast(unsigned, f); return (u + 0x7fffu + ((u >> 16) & 1u)) >> 16; }
__device__ __forceinline__ unsigned pk2(float lo, float hi) { return f2bf(lo) | (f2bf(hi) << 16); }
__device__ __forceinline__ unsigned cvt_pk_bf16(float lo, float hi) { unsigned r; asm volatile("v_cvt_pk_bf16_f32 %0, %1, %2" : "=v"(r) : "v"(lo), "v"(hi)); return r; }
__device__ __forceinline__ float bf_lo(unsigned w) { return __builtin_bit_cast(float, w << 16); }
__device__ __forceinline__ float bf_hi(unsigned w) { return __builtin_bit_cast(float, w & 0xffff0000u); }
__device__ __forceinline__ float wave_sum(float v) {
#pragma unroll
    for (int o = 1; o < 64; o <<= 1) v += __shfl_xor(v, o);
    return v;
}
__device__ __forceinline__ float fast_sigmoid(float x) { return __builtin_amdgcn_rcpf(1.0f + __builtin_amdgcn_exp2f(-1.4426950408889634f * x)); }
__device__ __forceinline__ float gelu_tanh(float x) {
    const float u2 = 1.5957691216057308f * (x + 0.044715f * x * x * x);
    return x * fast_sigmoid(u2);
}

#define DPP_STEP(v, ctrl, rmask) ((v) + __builtin_bit_cast(float, __builtin_amdgcn_update_dpp(0, __builtin_bit_cast(int, (v)), (ctrl), (rmask), 0xF, false)))
__device__ __forceinline__ float wave_sum_dpp(float v) {
    v = DPP_STEP(v, 0xB1, 0xF);
    v = DPP_STEP(v, 0x4E, 0xF);
    v = DPP_STEP(v, 0x141, 0xF);
    v = DPP_STEP(v, 0x140, 0xF);
    v = DPP_STEP(v, 0x142, 0xA);
    v = DPP_STEP(v, 0x143, 0xC);
    return __builtin_bit_cast(float, __builtin_amdgcn_readlane(__builtin_bit_cast(int, v), 63));
}
#define LDS_WAIT() asm volatile("s_waitcnt lgkmcnt(0)" ::: "memory")
#define VM_WAIT() asm volatile("s_waitcnt vmcnt(0)" ::: "memory")

#define XB_TMO      128
#define XB_XCNT(j)  (256  + 64 * (j))
#define XB_XSUB(j)  (1280 + 64 * (j))
#define XB_XGEN(j)  (2304 + 64 * (j))
#define XB_TOP      3328
#define XB_TOPGEN   3392
#define XCD_BAR_WORDS 3456
#define XB_SPIN_CAP (1u << 22)
__device__ __forceinline__ unsigned xb_ld(unsigned* p)              { return __hip_atomic_load(p, __ATOMIC_RELAXED, __HIP_MEMORY_SCOPE_AGENT); }
__device__ __forceinline__ unsigned xb_add(unsigned* p, unsigned v) { return __hip_atomic_fetch_add(p, v, __ATOMIC_RELAXED, __HIP_MEMORY_SCOPE_AGENT); }
__device__ __forceinline__ unsigned xb_xcc_id() { return (unsigned)__builtin_amdgcn_s_getreg((3 << 11) | 20) & 0xFu; }
#define XB_SPIN(cond, bar) do { unsigned _sp = 0; while (cond) { __builtin_amdgcn_s_sleep(1); \
    if ((++_sp & 255u) == 0u) { if (xb_ld(&(bar)[XB_TMO])) break; if (_sp > XB_SPIN_CAP) { atomicAdd(&(bar)[XB_TMO], 1u); break; } } } } while (0)
struct XcdBarrier { unsigned* bar; unsigned x; volatile LAS unsigned* st; };
__device__ __forceinline__ XcdBarrier xcd_barrier_post(unsigned* bar, volatile LAS unsigned* st) {
    XcdBarrier b; b.bar = bar; b.x = xb_xcc_id(); b.st = st;
    if (threadIdx.x == 0) (void)xb_add(&bar[XB_XCNT(b.x)], 1u);
    return b;
}
__device__ __forceinline__ void xcd_barrier_complete(unsigned* bar, unsigned x, unsigned& nloc, unsigned& nx) {
    const unsigned G = gridDim.x * gridDim.y * gridDim.z;
    unsigned sum, cnt, mine, sp = 0u;
    for (;;) {
        sum = 0u; cnt = 0u; mine = 0u;
#pragma unroll
        for (unsigned j = 0; j < 16; ++j) { const unsigned c = xb_ld(&bar[XB_XCNT(j)]); sum += c; cnt += (c > 0u) ? 1u : 0u; mine = (j == x) ? c : mine; }
        if (sum == G) break;
        __builtin_amdgcn_s_sleep(1);
        if ((++sp & 255u) == 0u) { if (xb_ld(&bar[XB_TMO])) break; if (sp > XB_SPIN_CAP) { atomicAdd(&bar[XB_TMO], 1u); break; } }
    }
    nloc = mine > 0u ? mine : 1u; nx = cnt > 0u ? cnt : 1u;
}
__device__ __forceinline__ void xcd_barrier(const XcdBarrier& b) {
    asm volatile("s_waitcnt vmcnt(0)" ::: "memory");
    __syncthreads();
    if (threadIdx.x == 0) {
        unsigned* bar = b.bar;
        __builtin_amdgcn_s_waitcnt(0);
        unsigned nloc = b.st[0], nx = b.st[1];
        if (nloc == 0u) { xcd_barrier_complete(bar, b.x, nloc, nx); b.st[0] = nloc; b.st[1] = nx; }
        const unsigned old = xb_add(&bar[XB_XSUB(b.x)], 1u);
        const unsigned gen = old / nloc;
        if (old + 1u == (gen + 1u) * nloc) {
            __builtin_amdgcn_fence(__ATOMIC_RELEASE, "agent");
            asm volatile("s_waitcnt vmcnt(0)" ::: "memory");
            const unsigned og = xb_add(&bar[XB_TOP], 1u);
            const unsigned tg = og / nx;
            if (og + 1u == (tg + 1u) * nx) xb_add(&bar[XB_TOPGEN], 1u);
            else XB_SPIN(xb_ld(&bar[XB_TOPGEN]) == tg, bar);
            __builtin_amdgcn_fence(__ATOMIC_ACQUIRE, "agent");
            xb_add(&bar[XB_XGEN(b.x)], 1u);
            asm volatile("s_waitcnt vmcnt(0)" ::: "memory");
        } else {
            XB_SPIN(xb_ld(&bar[XB_XGEN(b.x)]) == gen, bar);
            __builtin_amdgcn_fence(__ATOMIC_ACQUIRE, "agent");
            asm volatile("s_waitcnt vmcnt(0)" ::: "memory");
        }
    }
    __syncthreads();
}

namespace pg8 {
constexpr int BM = 256, BK = 64, HALF = 128, HTB = HALF * BK * 2, STAGE_BYTES = 8 * HTB, NXCD = 8, WGM = 4;
__host__ __device__ __forceinline__ int lds_byte(int r, int c) { const int st = (r >> 4) * 2 + (c >> 5), rr = r & 15, cc = c & 31, ob = rr * 64 + cc * 2; return st * 1024 + (ob ^ (((ob >> 9) & 1) << 5)); }
__host__ __device__ __forceinline__ void stage_rc(int b, int& R, int& C) { const int st = b / 1024, sb = b % 1024, swz = sb ^ (((sb >> 9) & 1) << 5); R = (st >> 1) * 16 + swz / 64; C = (st & 1) * 32 + (swz % 64) / 2; }
__host__ __device__ __forceinline__ int perm32(int rho) { const int n = rho >> 4, i = rho & 15; return 8 * (i >> 2) + 4 * n + (i & 3); }

struct Seg { const char* A; const char* B; int pm, pn, kind, aux; };

__device__ __forceinline__ bool static_tile(int i, int G, int c, int nM, int nN, int& pm, int& pn) {
    const int nwg = nM * nN; const long L = (long)i * G + c; if (L >= nwg) return false;
    int wgid = (int)L; { const int q = nwg / NXCD, r = nwg % NXCD, xcd = wgid % NXCD, off = wgid / NXCD; wgid = (xcd < r ? xcd * (q + 1) : r * (q + 1) + (xcd - r) * q) + off; }
    const int nig = WGM * nN, gid = wgid / nig, fm = gid * WGM, gsz = (nM - fm) < WGM ? (nM - fm) : WGM;
    pm = fm + ((wgid % nig) % gsz); pn = (wgid % nig) / gsz; return true;
}

template <class Epi, class Sched, bool GATHER>
__device__ __forceinline__ void gemm_phase(LAS unsigned char* lds, const Sched& S, const Epi& E, const int lda, const int ldb, const int nt) {
    const int tid = threadIdx.x, wid = __builtin_amdgcn_readfirstlane(tid >> 6), lane = tid & 63, wr = wid >> 2, wc = wid & 3, fr = lane & 15, fq = lane >> 4;
    unsigned voffA[2][2], nvoffA[2][2], voffB[2]; int RR[2], CC[2];
    const size_t hstepA = (size_t)HALF * lda * 2, hstepB = (size_t)HALF * ldb * 2, kstep = (size_t)(BK * 2);
#pragma unroll
    for (int i = 0; i < 2; ++i) { int R, C; stage_rc(tid * 16 + i * 8192, R, C); RR[i] = R; CC[i] = C; const int Rb = Epi::PERM ? ((R & ~31) + perm32(R & 31)) : R;
        voffA[0][i] = (unsigned)(R * lda + C) * 2u; voffA[1][i] = voffA[0][i] + (unsigned)hstepA; voffB[i] = (unsigned)(Rb * ldb + C) * 2u;
        nvoffA[0][i] = voffA[0][i]; nvoffA[1][i] = voffA[1][i]; }
    const unsigned ldsw = (unsigned)wid * 1024u;
    const int aoff = lds_byte(wr * 64 + fr, fq * 8), boff = lds_byte(wc * 32 + fr, fq * 8);
#define PG8_SA(b, h) (((b) * 2 + (h)) * HTB)
#define PG8_SB(b, h) ((4 + (b) * 2 + (h)) * HTB)
#define PG8_STAGEA(bufoff, gbase, vo) do { _Pragma("unroll") for (int _i = 0; _i < 2; ++_i) \
        __builtin_amdgcn_global_load_lds((const unsigned*)((const char*)(gbase) + (vo)[_i]), (LAS unsigned*)(lds + (bufoff) + ldsw + _i * 8192), 16, 0, 0); } while (0)
#define PG8_STAGEB(bufoff, gbase) do { _Pragma("unroll") for (int _i = 0; _i < 2; ++_i) \
        __builtin_amdgcn_global_load_lds((const unsigned*)((const char*)(gbase) + voffB[_i]), (LAS unsigned*)(lds + (bufoff) + ldsw + _i * 8192), 16, 0, 0); } while (0)
#define PG8_LDA(dst, b, h) do { _Pragma("unroll") for (int m = 0; m < 4; ++m) _Pragma("unroll") for (int k = 0; k < 2; ++k) dst[m][k] = *(const LAS bf16x8*)(lds + PG8_SA(b, h) + aoff + m * 2048 + k * 1024); } while (0)
#define PG8_LDB(dst, b, h) do { _Pragma("unroll") for (int n = 0; n < 2; ++n) _Pragma("unroll") for (int k = 0; k < 2; ++k) dst[n][k] = *(const LAS bf16x8*)(lds + PG8_SB(b, h) + boff + n * 2048 + k * 1024); } while (0)
#define PG8_MMA(ai, bj, At, Bt) do { __builtin_amdgcn_s_setprio(1); _Pragma("unroll") for (int m = 0; m < 4; ++m) _Pragma("unroll") for (int n = 0; n < 2; ++n) _Pragma("unroll") for (int k = 0; k < 2; ++k) \
        acc[ai][bj][m][n] = __builtin_amdgcn_mfma_f32_16x16x32_bf16(Bt[n][k], At[m][k], acc[ai][bj][m][n], 0, 0, 0); __builtin_amdgcn_s_setprio(0); } while (0)
#define PG8_WAIT_V(n) asm volatile("s_waitcnt vmcnt(" #n ")" ::: "memory")
#define PG8_WAIT_L(n) asm volatile("s_waitcnt lgkmcnt(" #n ")" ::: "memory")
#define PG8_BAR __builtin_amdgcn_s_barrier()
#define PG8_SCHED __builtin_amdgcn_sched_barrier(0)
    Seg cur, nxt; int ui = 0;
    if (!S.next(0, cur)) return;
    f32x4 acc[2][2][4][2];
#pragma unroll
    for (int a = 0; a < 2; ++a)
#pragma unroll
        for (int b = 0; b < 2; ++b)
#pragma unroll
            for (int m = 0; m < 4; ++m)
#pragma unroll
                for (int n = 0; n < 2; ++n) acc[a][b][m][n] = (f32x4){0.f, 0.f, 0.f, 0.f};
    bf16x8 At[4][2], B0[2][2], B1[2][2];
    const char* cA = cur.A; const char* cB = cur.B;
    if constexpr (GATHER) {
#pragma unroll
        for (int h = 0; h < 2; ++h)
#pragma unroll
            for (int i = 0; i < 2; ++i) voffA[h][i] = (unsigned)(S.row(cur, RR[i] + HALF * h) * lda + CC[i]) * 2u;
    }
    PG8_STAGEB(PG8_SB(0, 0), cB); PG8_STAGEB(PG8_SB(0, 1), cB + hstepB); PG8_STAGEA(PG8_SA(0, 0), cA, voffA[0]); PG8_STAGEA(PG8_SA(0, 1), cA, voffA[1]);
    if (wr == 1) PG8_BAR;
    PG8_WAIT_V(2); PG8_BAR;
    PG8_STAGEB(PG8_SB(1, 0), cB + kstep); PG8_STAGEA(PG8_SA(1, 0), cA + kstep, voffA[0]); PG8_STAGEB(PG8_SB(1, 1), cB + hstepB + kstep);
    PG8_WAIT_V(6); PG8_BAR;
    for (;;) {
        const bool has_next = S.next(ui + 1, nxt);
        const char* nA = has_next ? nxt.A : cA; const char* nB = has_next ? nxt.B : cB;
        if constexpr (GATHER) {
            if (has_next) {
#pragma unroll
                for (int h = 0; h < 2; ++h)
#pragma unroll
                    for (int i = 0; i < 2; ++i) nvoffA[h][i] = (unsigned)(S.row(nxt, RR[i] + HALF * h) * lda + CC[i]) * 2u;
            } else {
#pragma unroll
                for (int h = 0; h < 2; ++h)
#pragma unroll
                    for (int i = 0; i < 2; ++i) nvoffA[h][i] = voffA[h][i];
            }
        }
        for (int t = 0; t < nt; t += 2) {
            const bool last = (t == nt - 2);
            const char* a1 = cA + (size_t)(t + 1) * kstep;
            const char* a2 = last ? nA : cA + (size_t)(t + 2) * kstep; const char* b2 = last ? nB : cB + (size_t)(t + 2) * kstep;
            const char* a3 = a2 + kstep; const char* b3 = b2 + kstep;
            unsigned v20, v21, v30, v31, w20, w21;
            if constexpr (GATHER) { v20 = last ? nvoffA[0][0] : voffA[0][0]; v21 = last ? nvoffA[0][1] : voffA[0][1]; w20 = last ? nvoffA[1][0] : voffA[1][0]; w21 = last ? nvoffA[1][1] : voffA[1][1]; }
            else { v20 = voffA[0][0]; v21 = voffA[0][1]; w20 = voffA[1][0]; w21 = voffA[1][1]; }
            v30 = v20; v31 = v21;
            const unsigned vh0[2] = {v20, v21}, vh1[2] = {w20, w21};
            PG8_LDB(B0, 0, 0); PG8_LDB(B1, 0, 1); PG8_SCHED; PG8_LDA(At, 0, 0); PG8_STAGEA(PG8_SA(1, 1), a1, voffA[1]);
            PG8_WAIT_V(8); PG8_WAIT_L(0); PG8_BAR; PG8_MMA(0, 0, At, B0); PG8_MMA(0, 1, At, B1); PG8_BAR; PG8_SCHED;
            PG8_LDA(At, 0, 1); PG8_STAGEB(PG8_SB(0, 0), b2); PG8_STAGEB(PG8_SB(0, 1), b2 + hstepB); PG8_STAGEA(PG8_SA(0, 0), a2, vh0);
            PG8_WAIT_V(8); PG8_WAIT_L(0); PG8_BAR; PG8_MMA(1, 0, At, B0); PG8_MMA(1, 1, At, B1); PG8_BAR; PG8_SCHED;
            PG8_LDB(B0, 1, 0); PG8_LDB(B1, 1, 1); PG8_SCHED; PG8_LDA(At, 1, 0); PG8_STAGEA(PG8_SA(0, 1), a2, vh1);
            PG8_WAIT_V(8); PG8_WAIT_L(0); PG8_BAR; PG8_MMA(0, 0, At, B0); PG8_MMA(0, 1, At, B1); PG8_BAR; PG8_SCHED;
            PG8_LDA(At, 1, 1); PG8_STAGEB(PG8_SB(1, 0), b3); PG8_STAGEB(PG8_SB(1, 1), b3 + hstepB); PG8_STAGEA(PG8_SA(1, 0), a3, vh0);
            PG8_WAIT_V(8); PG8_WAIT_L(0); PG8_BAR; PG8_MMA(1, 0, At, B0); PG8_MMA(1, 1, At, B1); PG8_BAR; PG8_SCHED;
            (void)v30; (void)v31;
        }
        if (wr == 0) PG8_BAR;
        asm volatile("s_nop 15\n\ts_nop 15" ::: "memory");
        if (cur.kind & 2) E(acc, cur, wr, wc, fr, fq); else E.mid(acc, cur, wr, wc, fr, fq);
        if (!has_next) break;
        if (nxt.kind & 1) {
#pragma unroll
            for (int a = 0; a < 2; ++a)
#pragma unroll
                for (int b = 0; b < 2; ++b)
#pragma unroll
                    for (int m = 0; m < 4; ++m)
#pragma unroll
                        for (int n = 0; n < 2; ++n) acc[a][b][m][n] = (f32x4){0.f, 0.f, 0.f, 0.f};
        }
        cur = nxt; cA = nA; cB = nB; ++ui;
        if constexpr (GATHER) {
#pragma unroll
            for (int h = 0; h < 2; ++h)
#pragma unroll
                for (int i = 0; i < 2; ++i) voffA[h][i] = nvoffA[h][i];
        }
        if (wr == 1) PG8_BAR;
    }
    PG8_WAIT_V(0);
    PG8_BAR;
#undef PG8_SA
#undef PG8_SB
#undef PG8_STAGEA
#undef PG8_STAGEB
#undef PG8_LDA
#undef PG8_LDB
#undef PG8_MMA
#undef PG8_WAIT_V
#undef PG8_WAIT_L
#undef PG8_BAR
#undef PG8_SCHED
}
}

constexpr int NWAVES = 8;
struct Args { const void* in[18]; float* out; unsigned char* ws; int ph_lo, ph_hi; };
struct Frame {
    LAS unsigned char* lds; int tid, lane, wave, G, bx; float* out; unsigned char* ws;
};

__device__ __forceinline__ int win_src(int n) {
    if (n < 2048) { const int seg = n >> 10, h = (n >> 7) & 7, p = n & 127; return seg * 1024 + h * 128 + (p >> 1) + 64 * (p & 1); }
    if (n < 3072) return SRC_V + (n - 2048);
    if (n < 4096) return SRC_SU + (n - 3072);
    if (n < 5120) return SRC_SV + (n - 4096);
    if (n < 6144) return SRC_GA + (n - 5120);
    if (n < 7168) return SRC_GB + (n - 6144);
    if (n < 7680) { const int m = n - 7168, h = m >> 6, p = m & 63; return SRC_QI + h * 64 + (p >> 1) + 32 * (p & 1); }
    if (n < 7744) { const int p = n - 7680; return SRC_KI + (p >> 1) + 32 * (p & 1); }
    if (n < 7752) return SRC_WI + (n - 7744);
    return -1;
}
__device__ __forceinline__ int wein_src(int r) { const int t = r >> 8, q = r & 255; return (q < 128) ? (128 * t + q) : (256 + 128 * t + (q - 128)); }

template <int MAP>
__device__ __forceinline__ void transpose_item(const float* W, int K, int N, int NDEST, bf16_t* WT, LAS float* scr, int item, int lane) {
    const int nblk = NDEST / 32, kb = item / nblk, nb = item % nblk, k0 = 64 * kb, n0 = 32 * nb;
    const int nd = n0 + (lane & 31); int src = nd; if (MAP == 1) src = win_src(nd); if (MAP == 2) src = wein_src(nd);
    float tv[32];
#pragma unroll
    for (int i = 0; i < 32; ++i) { const int kk = 2 * i + (lane >> 5); tv[i] = (src >= 0) ? W[(size_t)(k0 + kk) * N + src] : 0.f; }
#pragma unroll
    for (int i = 0; i < 32; ++i) { const int kk = 2 * i + (lane >> 5); scr[kk * 33 + (lane & 31)] = tv[i]; }
    LDS_WAIT(); asm volatile("" ::: "memory");
    const int c = lane & 7;
#pragma unroll
    for (int j = 0; j < 4; ++j) { const int n = (lane >> 3) + 8 * j; const LAS float* s = scr + (8 * c) * 33 + n;
        u32x4 o; o.x = pk2(s[0 * 33], s[1 * 33]); o.y = pk2(s[2 * 33], s[3 * 33]); o.z = pk2(s[4 * 33], s[5 * 33]); o.w = pk2(s[6 * 33], s[7 * 33]);
        *(u32x4*)(WT + (size_t)(n0 + n) * K + k0 + 8 * c) = o; }
    LDS_WAIT(); asm volatile("" ::: "memory");
}
__device__ __forceinline__ void split_pair(float a, float b, unsigned& hi, unsigned& lo) {
    const unsigned ua = __builtin_bit_cast(unsigned, a), ub = __builtin_bit_cast(unsigned, b);
    hi = (ub & 0xffff0000u) | (ua >> 16);
    lo = cvt_pk_bf16(a - __builtin_bit_cast(float, ua & 0xffff0000u), b - __builtin_bit_cast(float, ub & 0xffff0000u));
}
__device__ __forceinline__ void rms_row_to_bf16(const float* xrow, const float* g, bf16_t* orow, int lane) {
    const f32x4* xr = (const f32x4*)xrow + lane; const f32x4* gr = (const f32x4*)g + lane;
    f32x4 v[4]; float s = 0.f;
#pragma unroll
    for (int j = 0; j < 4; ++j) { v[j] = xr[64 * j]; s += (v[j].x * v[j].x + v[j].y * v[j].y) + (v[j].z * v[j].z + v[j].w * v[j].w); }
    const float rstd = 1.0f / sqrtf(wave_sum(s) * (1.f / D) + EPS);
    u64* o8 = (u64*)orow + lane;
#pragma unroll
    for (int j = 0; j < 4; ++j) { const f32x4 gg = gr[64 * j];
        o8[64 * j] = (u64)pk2(v[j].x * rstd * gg.x, v[j].y * rstd * gg.y) | ((u64)pk2(v[j].z * rstd * gg.z, v[j].w * rstd * gg.w) << 32); }
}
__device__ __forceinline__ void p0_prep(const Args& A, Frame& F) {
    LAS float* scr = (LAS float*)(F.lds + F.wave * 16384);
    const int gw = F.bx * NWAVES + F.wave, NGW = F.G * NWAVES;
    bf16_t* WinT = (bf16_t*)(F.ws + WS_WIN); bf16_t* WaT = (bf16_t*)(F.ws + WS_WA); bf16_t* WbT = (bf16_t*)(F.ws + WS_WB); bf16_t* WoT = (bf16_t*)(F.ws + WS_WO);
    constexpr int I_IN = (D / 64) * (NPROJ / 32), I_SQ = (D / 64) * (D / 32);
    for (int it = gw; it < I_IN + 3 * I_SQ; it += NGW) {
        int r = it;
        if (r < I_IN) { transpose_item<1>(((const float*)A.in[3]), D, NPROJ_SRC, NPROJ, WinT, scr, r, F.lane); continue; } r -= I_IN;
        if (r < I_SQ) { transpose_item<0>(((const float*)A.in[7]), D, D, D, WaT, scr, r, F.lane); continue; } r -= I_SQ;
        if (r < I_SQ) { transpose_item<0>(((const float*)A.in[8]), D, D, D, WbT, scr, r, F.lane); continue; } r -= I_SQ;
        transpose_item<0>(((const float*)A.in[9]), D, D, D, WoT, scr, r, F.lane);
    }
    { unsigned* WIMG = (unsigned*)(F.ws + WS_WRT); const float* g2 = (const float*)A.in[10];
      for (int i = F.bx * 512 + F.tid; i < 36 * 512; i += F.G * 512) { const int c = i >> 9, k = (i & 511) * 2;
          const float w0 = (c < 4) ? ((const float*)A.in[11])[k * 4 + c] : ((const float*)A.in[13])[k * 32 + (c - 4)], w1 = (c < 4) ? ((const float*)A.in[11])[(k + 1) * 4 + c] : ((const float*)A.in[13])[(k + 1) * 32 + (c - 4)];
          unsigned hi, lo; split_pair(w0 * g2[k], w1 * g2[k + 1], hi, lo); WIMG[i] = hi; WIMG[36 * 512 + i] = lo; } }
    bf16_t* XN1 = (bf16_t*)(F.ws + WS_XN1); f32x2* ROPE = (f32x2*)(F.ws + WS_ROPE);
    const float inv = __builtin_amdgcn_exp2f(-(float)F.lane * (13.287712379549449f / 64.0f));
    for (int m0 = gw; m0 < T; m0 += 2 * NGW) {
        const int m1 = (m0 + NGW < T) ? m0 + NGW : m0;
        const f32x4* x0 = (const f32x4*)(((const float*)A.in[0]) + (size_t)m0 * D) + F.lane; const f32x4* x1 = (const f32x4*)(((const float*)A.in[0]) + (size_t)m1 * D) + F.lane;
        const f32x4* gr = (const f32x4*)((const float*)A.in[2]) + F.lane;
        f32x4 v0[4], v1[4]; float s0 = 0.f, s1 = 0.f;
#pragma unroll
        for (int j = 0; j < 4; ++j) { v0[j] = x0[64 * j]; v1[j] = x1[64 * j]; }
        const float ang0 = (float)((const int*)A.in[1])[m0] * inv, ang1 = (float)((const int*)A.in[1])[m1] * inv;
#pragma unroll
        for (int j = 0; j < 4; ++j) { s0 += (v0[j].x * v0[j].x + v0[j].y * v0[j].y) + (v0[j].z * v0[j].z + v0[j].w * v0[j].w); s1 += (v1[j].x * v1[j].x + v1[j].y * v1[j].y) + (v1[j].z * v1[j].z + v1[j].w * v1[j].w); }
        const float r0 = 1.0f / sqrtf(wave_sum(s0) * (1.f / D) + EPS), r1 = 1.0f / sqrtf(wave_sum(s1) * (1.f / D) + EPS);
        u64* o0 = (u64*)(XN1 + (size_t)m0 * D) + F.lane; u64* o1 = (u64*)(XN1 + (size_t)m1 * D) + F.lane;
#pragma unroll
        for (int j = 0; j < 4; ++j) { const f32x4 gg = gr[64 * j];
            o0[64 * j] = (u64)pk2(v0[j].x * r0 * gg.x, v0[j].y * r0 * gg.y) | ((u64)pk2(v0[j].z * r0 * gg.z, v0[j].w * r0 * gg.w) << 32);
            if (m1 != m0) o1[64 * j] = (u64)pk2(v1[j].x * r1 * gg.x, v1[j].y * r1 * gg.y) | ((u64)pk2(v1[j].z * r1 * gg.z, v1[j].w * r1 * gg.w) << 32); }
        ROPE[(size_t)m0 * 64 + F.lane] = (f32x2){cosf(ang0), sinf(ang0)};
        if (m1 != m0) ROPE[(size_t)m1 * 64 + F.lane] = (f32x2){cosf(ang1), sinf(ang1)};
    }
}


template <int OFF> __device__ __forceinline__ void ald16(f32x4& d, const void* p) { asm volatile("global_load_dwordx4 %0, %1, off offset:%2" : "=v"(d) : "v"(p), "i"(OFF) : "memory"); }
template <int OFF> __device__ __forceinline__ void ald16u(u32x4& d, const void* p) { asm volatile("global_load_dwordx4 %0, %1, off offset:%2" : "=v"(d) : "v"(p), "i"(OFF) : "memory"); }
__device__ __forceinline__ void ald4(unsigned& d, const void* p) { asm volatile("global_load_dword %0, %1, off" : "=v"(d) : "v"(p) : "memory"); }
__device__ __forceinline__ void ald4f(float& d, const void* p) { asm volatile("global_load_dword %0, %1, off" : "=v"(d) : "v"(p) : "memory"); }
#define AWAIT8(a, b, c, d, e, f, g, h) asm volatile("s_waitcnt vmcnt(0)" : "+v"(a), "+v"(b), "+v"(c), "+v"(d), "+v"(e), "+v"(f), "+v"(g), "+v"(h) :: "memory")
#define AWAIT4(a, b, c, d) asm volatile("s_waitcnt vmcnt(0)" : "+v"(a), "+v"(b), "+v"(c), "+v"(d) :: "memory")

struct SchedDense {
    const char* A; const char* B; int nM, nN, G, c; size_t tstepA, tstepB;
    __device__ __forceinline__ bool next(int i, pg8::Seg& s) const {
        int pm, pn; if (!pg8::static_tile(i, G, c, nM, nN, pm, pn)) return false;
        s.pm = pm; s.pn = pn; s.A = A + (size_t)pm * tstepA; s.B = B + (size_t)pn * tstepB; s.kind = 3; s.aux = 0; return true;
    }
    __device__ __forceinline__ int row(const pg8::Seg&, int) const { return 0; }
};

__device__ __forceinline__ u32x4 pack8v(f32x4 a, f32x4 b) { u32x4 w; w.x = cvt_pk_bf16(a[0], a[1]); w.y = cvt_pk_bf16(a[2], a[3]); w.z = cvt_pk_bf16(b[0], b[1]); w.w = cvt_pk_bf16(b[2], b[3]); return w; }
__device__ __forceinline__ void rope4(f32x4& v, f32x4 cs) {
    const float a0 = v[0] * cs[0] - v[1] * cs[1], a1 = v[1] * cs[0] + v[0] * cs[1], b0 = v[2] * cs[2] - v[3] * cs[3], b1 = v[3] * cs[2] + v[2] * cs[3];
    v = (f32x4){a0, a1, b0, b1};
}
struct EpiProj {
    static constexpr bool PERM = true;
    unsigned char* ws; unsigned char* outb;
    __device__ __forceinline__ void mid(f32x4 (&)[2][2][4][2], const pg8::Seg&, int, int, int, int) const {}
    __device__ __forceinline__ void operator()(f32x4 (&acc)[2][2][4][2], const pg8::Seg& u, int wr, int wc, int fr, int fq) const {
        const int pn = u.pn, row0 = u.pm * 256 + wr * 64 + fr, cl = wc * 32 + 8 * fq;
        const float* ROPE = (const float*)(ws + WS_ROPE);
        if (pn < 8) {
            bf16_t* dst = (bf16_t*)(ws + (pn < 4 ? WS_Q : WS_K)) + (pn & 3) * 256 + cl;
            f32x4 c0[2][4], c1[2][4];
#pragma unroll
            for (int ai = 0; ai < 2; ++ai)
#pragma unroll
                for (int m = 0; m < 4; ++m) { const float* rp = ROPE + ((size_t)(row0 + ai * 128 + m * 16) * 64 + 16 * wc + 4 * fq) * 2; ald16<0>(c0[ai][m], rp); ald16<16>(c1[ai][m], rp); }
            AWAIT8(c0[0][0], c1[0][0], c0[0][1], c1[0][1], c0[0][2], c1[0][2], c0[0][3], c1[0][3]);
            AWAIT8(c0[1][0], c1[1][0], c0[1][1], c1[1][1], c0[1][2], c1[1][2], c0[1][3], c1[1][3]);
#pragma unroll
            for (int ai = 0; ai < 2; ++ai) {
#pragma unroll
                for (int m = 0; m < 4; ++m) { const int row = row0 + ai * 128 + m * 16;
#pragma unroll
                    for (int bj = 0; bj < 2; ++bj) { f32x4 v0 = acc[ai][bj][m][0], v1 = acc[ai][bj][m][1]; rope4(v0, c0[ai][m]); rope4(v1, c1[ai][m]);
                        *(u32x4*)(dst + (size_t)row * 1024 + bj * 128) = pack8v(v0, v1); } } }
        } else if (pn < 28) {
            const int kind = (pn - 8) >> 2;
            bf16_t* dst;
            if (kind == 0) dst = (bf16_t*)(ws + WS_V); else if (kind == 1) dst = (bf16_t*)(ws + WS_SU); else if (kind == 2) dst = (bf16_t*)(ws + WS_SV);
            else if (kind == 3) dst = (bf16_t*)outb; else dst = (bf16_t*)(outb + 64 * MiB);
            dst += (pn & 3) * 256 + cl;
            f32x2* SVST = (f32x2*)(ws + WS_SVST);
#pragma unroll
            for (int ai = 0; ai < 2; ++ai)
#pragma unroll
                for (int m = 0; m < 4; ++m) { const int row = row0 + ai * 128 + m * 16;
#pragma unroll
                    for (int bj = 0; bj < 2; ++bj) { f32x4 v0 = acc[ai][bj][m][0], v1 = acc[ai][bj][m][1];
                        if (kind == 1 || kind == 2) {
#pragma unroll
                            for (int j = 0; j < 4; ++j) { v0[j] = gelu_tanh(v0[j]); v1[j] = gelu_tanh(v1[j]); } }
                        if (kind >= 3) {
#pragma unroll
                            for (int j = 0; j < 4; ++j) { v0[j] = fast_sigmoid(v0[j]); v1[j] = fast_sigmoid(v1[j]); } }
                        if (kind == 2) { float s = (v0[0] + v0[1]) + (v0[2] + v0[3]) + (v1[0] + v1[1]) + (v1[2] + v1[3]);
                            float q = (v0[0] * v0[0] + v0[1] * v0[1]) + (v0[2] * v0[2] + v0[3] * v0[3]) + (v1[0] * v1[0] + v1[1] * v1[1]) + (v1[2] * v1[2] + v1[3] * v1[3]);
                            s += __shfl_xor(s, 16); s += __shfl_xor(s, 32); q += __shfl_xor(q, 16); q += __shfl_xor(q, 32);
                            if (fq == 0) SVST[(size_t)row * 32 + (pn & 3) * 8 + bj * 4 + wc] = (f32x2){s, q}; }
                        *(u32x4*)(dst + (size_t)row * 1024 + bj * 128) = pack8v(v0, v1); } }
        } else {
#pragma unroll
            for (int ai = 0; ai < 2; ++ai)
#pragma unroll
              for (int mh = 0; mh < 2; ++mh) {
                f32x4 e[2][4];
#pragma unroll
                for (int mm = 0; mm < 2; ++mm) { const float* rp = ROPE + ((size_t)(row0 + ai * 128 + (2 * mh + mm) * 16) * 64 + 32 * (wc & 1) + 8 * fq) * 2;
                    ald16<0>(e[mm][0], rp); ald16<16>(e[mm][1], rp); ald16<32>(e[mm][2], rp); ald16<48>(e[mm][3], rp); }
                AWAIT8(e[0][0], e[0][1], e[0][2], e[0][3], e[1][0], e[1][1], e[1][2], e[1][3]);
#pragma unroll
                for (int mm = 0; mm < 2; ++mm) { const int m = 2 * mh + mm, row = row0 + ai * 128 + m * 16;
                    const f32x4 c0 = (f32x4){e[mm][0][0], e[mm][0][1], e[mm][1][0], e[mm][1][1]}, c1 = (f32x4){e[mm][2][0], e[mm][2][1], e[mm][3][0], e[mm][3][1]};
#pragma unroll
                    for (int bj = 0; bj < 2; ++bj) { f32x4 v0 = acc[ai][bj][m][0], v1 = acc[ai][bj][m][1];
                        if (pn < 30) { rope4(v0, c0); rope4(v1, c1); *(u32x4*)((bf16_t*)(ws + WS_QI) + (size_t)row * 512 + (pn - 28) * 256 + bj * 128 + cl) = pack8v(v0, v1); }
                        else if (bj == 0) {
                            if (wc < 2) { rope4(v0, c0); rope4(v1, c1); const int c8 = cl >> 3; *(u32x4*)((bf16_t*)(ws + WS_KI) + ((((size_t)row >> 5) * 4 + (c8 >> 1)) * 64 + (row & 31) + 32 * (c8 & 1)) * 8) = pack8v(v0, v1); }
                            else if (wc == 2 && fq == 0) { float* wi = (float*)(ws + WS_WI) + (size_t)row * 8; *(f32x4*)wi = v0; *(f32x4*)(wi + 4) = v1; } } } } }
        }
    }
};
__device__ __forceinline__ void p1_proj(const Args& A, Frame& F) {
    SchedDense S; S.A = (const char*)(F.ws + WS_XN1); S.B = (const char*)(F.ws + WS_WIN); S.nM = T / 256; S.nN = NPROJ / 256; S.G = F.G; S.c = F.bx; S.tstepA = (size_t)256 * D * 2; S.tstepB = (size_t)256 * D * 2;
    EpiProj E; E.ws = F.ws; E.outb = (unsigned char*)F.out;
    pg8::gemm_phase<EpiProj, SchedDense, false>(F.lds, S, E, D, D, D / 64);
}

constexpr int P2_SC = 0, P2_ROWB = 131072, P2_HIST = 147456;
__device__ __forceinline__ float fma1(float a, float b, float c) { float d; asm("v_fma_f32 %0, %1, %2, %3" : "=v"(d) : "v"(a), "v"(b), "v"(c)); return d; }
__device__ __forceinline__ float relu_bits(float x) { const int i = __builtin_bit_cast(int, x); return __builtin_bit_cast(float, i > 0 ? i : 0); }
__device__ __forceinline__ unsigned mono_key(float f) { const unsigned u = __builtin_bit_cast(unsigned, f); return u ^ ((u >> 31) ? 0xffffffffu : 0x80000000u); }

__device__ __forceinline__ int wave_isum_dpp(int v) {
#define IDPP(v, ctrl, rmask) ((v) + __builtin_amdgcn_update_dpp(0, (v), (ctrl), (rmask), 0xF, false))
    v = IDPP(v, 0xB1, 0xF); v = IDPP(v, 0x4E, 0xF); v = IDPP(v, 0x141, 0xF); v = IDPP(v, 0x140, 0xF); v = IDPP(v, 0x142, 0xA); v = IDPP(v, 0x143, 0xC);
#undef IDPP
    return __builtin_amdgcn_readlane(v, 63);
}
__device__ __forceinline__ void wave_isum2_dpp(int& a, int& b) {
#define IDPP(v, ctrl, rmask) ((v) + __builtin_amdgcn_update_dpp(0, (v), (ctrl), (rmask), 0xF, false))
    a = IDPP(a, 0xB1, 0xF); b = IDPP(b, 0xB1, 0xF); a = IDPP(a, 0x4E, 0xF); b = IDPP(b, 0x4E, 0xF); a = IDPP(a, 0x141, 0xF); b = IDPP(b, 0x141, 0xF);
    a = IDPP(a, 0x140, 0xF); b = IDPP(b, 0x140, 0xF); a = IDPP(a, 0x142, 0xA); b = IDPP(b, 0x142, 0xA); a = IDPP(a, 0x143, 0xC); b = IDPP(b, 0x143, 0xC);
#undef IDPP
    a = __builtin_amdgcn_readlane(a, 63); b = __builtin_amdgcn_readlane(b, 63);
}
__device__ __forceinline__ void bit_transpose32(unsigned (&w)[32]) {
#pragma unroll
    for (int k = 0; k < 32; ++k) if (!(k & 16)) { const unsigned a = w[k], b = w[k + 16]; w[k] = __builtin_amdgcn_perm(b, a, 0x05040100u); w[k + 16] = __builtin_amdgcn_perm(b, a, 0x07060302u); }
#pragma unroll
    for (int k = 0; k < 32; ++k) if (!(k & 8)) { const unsigned a = w[k], b = w[k + 8]; w[k] = __builtin_amdgcn_perm(b, a, 0x06020400u); w[k + 8] = __builtin_amdgcn_perm(b, a, 0x07030501u); }
#pragma unroll
    for (int st = 0; st < 3; ++st) { const int j = 4 >> st; const unsigned m = (st == 0) ? 0x0F0F0F0Fu : (st == 1) ? 0x33333333u : 0x55555555u;
#pragma unroll
        for (int k = 0; k < 32; ++k) if (!(k & j)) { const unsigned a = w[k], b = w[k + j]; w[k] = (a & m) | ((b << j) & ~m); w[k + j] = ((a >> j) & m) | (b & ~m); } }
}
template <bool HI>
__device__ __forceinline__ void p2a_select_row(LAS unsigned char* lds, int wave, int lane, int q, int rowslot) {
    const LAS unsigned* sc = (const LAS unsigned*)(lds + P2_SC) + wave * 4096;
    unsigned lo[32], hi[32];
#pragma unroll
    for (int i = 0; i < 32; ++i) { lo[i] = sc[i * 64 + lane]; hi[i] = HI ? sc[(32 + i) * 64 + lane] : 0u; }
    __syncthreads();
    const int nv = ((q - lane) >> 6) + 1;
    unsigned Alo = nv >= 32 ? 0xffffffffu : ((1u << nv) - 1u), Ahi = (HI && nv > 32) ? (nv >= 64 ? 0xffffffffu : ((1u << (nv - 32)) - 1u)) : 0u;
    bit_transpose32(lo); if (HI) bit_transpose32(hi);
    unsigned Glo = 0u, Ghi = 0u; int above = 0, alive = q + 1;
    bool live = true;
#define P2_STEP(b) if (live) { if (above + alive == TOPK) live = false; else {     \
        const unsigned p1l = lo[b], p1h = hi[b], p0l = lo[b - 1], p0h = hi[b - 1]; \
        const unsigned a1l = Alo & p1l, a1h = Ahi & p1h, S3l = a1l & p0l, S3h = a1h & p0h, S2l = a1l ^ S3l, S2h = a1h ^ S3h; \
        const unsigned a0l = Alo ^ a1l, a0h = Ahi ^ a1h, S1l = a0l & p0l, S1h = a0h & p0h; \
        int x = (__builtin_popcount(S3l) + __builtin_popcount(S3h)) | ((__builtin_popcount(S2l) + __builtin_popcount(S2h)) << 16), y = __builtin_popcount(S1l) + __builtin_popcount(S1h); \
        wave_isum2_dpp(x, y); \
        const int C3 = x & 0xffff, C2 = x >> 16, C1 = y; \
        if (above + C3 >= TOPK) { Alo = S3l; Ahi = S3h; alive = C3; } \
        else if (above + C3 + C2 >= TOPK) { above += C3; Glo |= S3l; Ghi |= S3h; Alo = S2l; Ahi = S2h; alive = C2; } \
        else if (above + C3 + C2 + C1 >= TOPK) { above += C3 + C2; Glo |= a1l; Ghi |= a1h; Alo = S1l; Ahi = S1h; alive = C1; } \
        else { above += C3 + C2 + C1; Glo |= a1l | S1l; Ghi |= a1h | S1h; Alo = a0l ^ S1l; Ahi = a0h ^ S1h; alive -= C3 + C2 + C1; } } }
    P2_STEP(31) P2_STEP(29) P2_STEP(27) P2_STEP(25) P2_STEP(23) P2_STEP(21) P2_STEP(19) P2_STEP(17) P2_STEP(15) P2_STEP(13) P2_STEP(11) P2_STEP(9) P2_STEP(7) P2_STEP(5) P2_STEP(3) P2_STEP(1)
#undef P2_STEP
    const int need = TOPK - above, eqtot = alive;
    unsigned Tlo = Alo, Thi = Ahi;
    if (eqtot != need) {
        int rem = need; Tlo = 0u; Thi = 0u;
#pragma unroll
        for (int j = 0; j < (HI ? 64 : 32); ++j) { const bool eq = (((j < 32 ? Alo : Ahi) >> (j & 31)) & 1u) != 0u; const u64 e = __ballot(eq);
            const int rank = (int)__builtin_amdgcn_mbcnt_hi((unsigned)(e >> 32), __builtin_amdgcn_mbcnt_lo((unsigned)e, 0u));
            if (eq && rank < rem) { if (j < 32) Tlo |= 1u << (j & 31); else Thi |= 1u << (j & 31); }
            rem -= __builtin_popcountll(e); }
    }
    *((LAS u32x2*)(lds + P2_ROWB) + rowslot * 64 + lane) = (u32x2){Glo | Tlo, Ghi | Thi};
}

__device__ __forceinline__ void p2a_group(const Args& A, Frame& F, int b, int g) {
    LAS unsigned char* lds = F.lds; const int lane = F.lane, wave = F.wave, tid = F.tid;
    const int t0 = 32 * g; const size_t tb = (size_t)b * SEQ;
    const bf16_t* QI = (const bf16_t*)(F.ws + WS_QI); const bf16_t* KI = (const bf16_t*)(F.ws + WS_KI); const float* WI = (const float*)(F.ws + WS_WI);
    if (g < 8) {
        for (int idx = tid; idx < 32 * 64; idx += 512) { const int ql = idx >> 6, ln = idx & 63, t = t0 + ql; const int n = (t >= ln) ? ((t - ln) >> 6) + 1 : 0;
            const u64 w = (n >= 64) ? ~0ull : ((1ull << n) - 1ull);
            *((LAS u64*)(lds + P2_ROWB) + ql * 64 + ln) = w; }
    } else {
        const int r = lane & 31, hh = lane >> 5;
        bf16x8 af[2][4]; f32x4 wv[4][2]; bf16x8 bfr[4], nbf[4];
#define P2_ROUND_LOADS(q0_) do { \
            _Pragma("unroll") for (int mt = 0; mt < 2; ++mt) _Pragma("unroll") for (int ks = 0; ks < 4; ++ks) af[mt][ks] = *(const bf16x8*)(QI + (tb + (q0_) + (r & 7)) * 512 + (4 * mt + (r >> 3)) * 64 + 16 * ks + 8 * hh); \
            _Pragma("unroll") for (int a = 0; a < 4; ++a) { const float* wp = WI + (tb + (q0_) + 4 * hh + a) * 8; wv[a][0] = *(const f32x4*)wp; wv[a][1] = *(const f32x4*)(wp + 4); } \
            _Pragma("unroll") for (int ks = 0; ks < 4; ++ks) bfr[ks] = *(const bf16x8*)(KI + ((((tb >> 5) + wave) * 4 + ks) * 64 + lane) * 8); } while (0)
        P2_ROUND_LOADS(t0);
        for (int rd = 0; rd < 4; ++rd) {
            const int q0 = t0 + 8 * rd; const int nk32 = (q0 + 8 + 31) >> 5;
#define P2_TILE_LOAD(dst, kt_) do { _Pragma("unroll") for (int ks = 0; ks < 4; ++ks) dst[ks] = *(const bf16x8*)(KI + ((((tb >> 5) + (size_t)(kt_)) * 4 + ks) * 64 + lane) * 8); } while (0)
#define P2_TILE_COMPUTE(src, kt_) do { f32x16 c0 = {}, c1 = {}; \
                _Pragma("unroll") for (int ks = 0; ks < 4; ++ks) { c0 = __builtin_amdgcn_mfma_f32_32x32x16_bf16(af[0][ks], src[ks], c0, 0, 0, 0); c1 = __builtin_amdgcn_mfma_f32_32x32x16_bf16(af[1][ks], src[ks], c1, 0, 0, 0); } \
                _Pragma("unroll") for (int a = 0; a < 4; ++a) { float s = 0.f; \
                    _Pragma("unroll") for (int hl = 0; hl < 4; ++hl) { s = fma1(wv[a][0][hl], relu_bits(c0[4 * hl + a]), s); s = fma1(wv[a][1][hl], relu_bits(c1[4 * hl + a]), s); } \
                    *((LAS unsigned*)(lds + P2_SC) + (4 * hh + a) * 4096 + (kt_) * 32 + r) = mono_key(s); } } while (0)
            for (int kt = wave;;) {
                { const int kn = kt + 8, kl = kn < nk32 ? kn : kt; P2_TILE_LOAD(nbf, kl); __builtin_amdgcn_sched_barrier(0); P2_TILE_COMPUTE(bfr, kt); kt = kn; }
                if (kt >= nk32) break;
                { const int kn = kt + 8, kl = kn < nk32 ? kn : kt; P2_TILE_LOAD(bfr, kl); __builtin_amdgcn_sched_barrier(0); P2_TILE_COMPUTE(nbf, kt); kt = kn; }
                if (kt >= nk32) break;
            }
#undef P2_TILE_LOAD
#undef P2_TILE_COMPUTE
            if (rd < 3) P2_ROUND_LOADS(q0 + 8);
            __syncthreads();
            if (q0 < 2048) p2a_select_row<false>(lds, wave, lane, q0 + wave, 8 * rd + wave); else p2a_select_row<true>(lds, wave, lane, q0 + wave, 8 * rd + wave);
        }
#undef P2_ROUND_LOADS
    }
    __syncthreads();
    u64* MW = (u64*)(F.ws + WS_MASK) + ((size_t)(b * 128 + g) * 64) * 32;
    const int jmax_c = (t0 + 31) >> 6, jmax_w = 4 * (g >> 3) + 3;
    LAS u64* OUT = (LAS u64*)(lds + P2_SC);
    if (wave < 2) {
        unsigned w32[32];
#pragma unroll
        for (int ql = 0; ql < 32; ++ql) w32[ql] = *((const LAS unsigned*)(lds + P2_ROWB) + (ql * 64 + lane) * 2 + wave);
        bit_transpose32(w32);
        const int x = lane & 31, rr = (x & 3) | ((x >> 3) << 2), h = (x >> 2) & 1, w = 16 * (lane >> 5) + rr;
        LAS unsigned* O32 = (LAS unsigned*)(lds + P2_SC);
#pragma unroll
        for (int jj = 0; jj < 32; ++jj) O32[((32 * wave + jj) * 32 + w) * 2 + h] = w32[jj];
    }
    __syncthreads();
    for (int idx = tid; idx < (jmax_w + 1) * 32; idx += 512) MW[idx] = ((idx >> 5) <= jmax_c) ? OUT[idx] : 0ull;
    __syncthreads();
}
__device__ __forceinline__ void p2a_index(const Args& A, Frame& F) {
    for (int it = F.bx; it < NB * 64; it += F.G) { const int b = it >> 6, y = it & 63; p2a_group(A, F, b, 127 - y); p2a_group(A, F, b, y); }
}

constexpr int SG_WL = 0, SG_VT = 34816, SG_STAT = 69632, SG_BS = 70656, SG_LD = 136;
__device__ __forceinline__ void p2b_sgu(const Args& A, Frame& F) {
    LAS unsigned char* lds = F.lds; const int tid = F.tid, lane = F.lane, wave = F.wave;
    bf16_t* SU = (bf16_t*)(F.ws + WS_SU); const bf16_t* SV = (const bf16_t*)(F.ws + WS_SV); const float* SVST = (const float*)(F.ws + WS_SVST);
    LAS bf16_t* WL = (LAS bf16_t*)(lds + SG_WL); LAS bf16_t* VT = (LAS bf16_t*)(lds + SG_VT); LAS f32x2* ST = (LAS f32x2*)(lds + SG_STAT); LAS float* BS = (LAS float*)(lds + SG_BS);
    const int NIT = NB * 32 * 8, lr = lane & 15, kq = lane >> 4, sl = 16 * wave + lr;
    int g_loaded = -1; f32x4 gam[4][2];
    f32x4 st[4]; u32x4 vv[4]; u32x2 uu[8];
#define SG_LOADS(it_) do { const int g_ = (it_) & 7; const size_t tok0_ = (size_t)((it_) >> 3) * 128; \
        const float* sp_ = SVST + ((tok0_ + (tid >> 2)) * 32 + (tid & 3) * 8) * 2; \
        _Pragma("unroll") for (int j = 0; j < 4; ++j) st[j] = *(const f32x4*)(sp_ + 4 * j); \
        _Pragma("unroll") for (int i = 0; i < 4; ++i) vv[i] = *(const u32x4*)(SV + (tok0_ + sl) * 1024 + g_ * 128 + 8 * (4 * i + kq)); \
        _Pragma("unroll") for (int n = 0; n < 8; ++n) uu[n] = *(const u32x2*)(SU + (tok0_ + sl) * 1024 + g_ * 128 + 4 * kq + 16 * n); } while (0)
    if (F.bx < NIT) SG_LOADS(F.bx);
    for (int it = F.bx; it < NIT; it += F.G) {
        const int g = it & 7; const size_t tok0 = (size_t)(it >> 3) * 128;
        if (g != g_loaded) {
            if (g_loaded >= 0) __syncthreads();
            g_loaded = g;
            if (tid >= 128 && tid < 256) BS[tid - 128] = ((const float*)A.in[6])[g * 128 + (tid - 128)];
            const int t = tid >> 2, s0 = (tid & 3) * 32; const float* wp = ((const float*)A.in[5]) + ((size_t)g * 128 + t) * 128 + s0;
#pragma unroll
            for (int c = 0; c < 4; ++c) { const f32x4 a = *(const f32x4*)(wp + 8 * c), b = *(const f32x4*)(wp + 8 * c + 4); const int s = s0 + 8 * c;
                u32x4 o; o.x = pk2(s + 0 <= t ? a[0] : 0.f, s + 1 <= t ? a[1] : 0.f); o.y = pk2(s + 2 <= t ? a[2] : 0.f, s + 3 <= t ? a[3] : 0.f);
                o.z = pk2(s + 4 <= t ? b[0] : 0.f, s + 5 <= t ? b[1] : 0.f); o.w = pk2(s + 6 <= t ? b[2] : 0.f, s + 7 <= t ? b[3] : 0.f);
                *(LAS u32x4*)(WL + t * SG_LD + s) = o; }
#pragma unroll
            for (int i = 0; i < 4; ++i) { const float* gp = ((const float*)A.in[4]) + g * 128 + 8 * (4 * i + kq); gam[i][0] = *(const f32x4*)gp; gam[i][1] = *(const f32x4*)(gp + 4); }
        }
        { float sm = 0.f, sq = 0.f;
#pragma unroll
          for (int j = 0; j < 4; ++j) { sm += st[j].x + st[j].z; sq += st[j].y + st[j].w; }
          sm += __shfl_xor(sm, 1); sq += __shfl_xor(sq, 1); sm += __shfl_xor(sm, 2); sq += __shfl_xor(sq, 2);
          const float mu = sm * (1.f / 1024.f), var = sq * (1.f / 1024.f) - mu * mu;
          if ((tid & 3) == 0) ST[tid >> 2] = (f32x2){mu, 1.0f / sqrtf(var + EPS)}; }
        u32x4 cv[4]; u32x2 uc[8];
#pragma unroll
        for (int i = 0; i < 4; ++i) cv[i] = vv[i];
#pragma unroll
        for (int n = 0; n < 8; ++n) uc[n] = uu[n];
        if (it + F.G < NIT) SG_LOADS(it + F.G);
        __syncthreads();
        { const f32x2 sv = ST[sl];
#pragma unroll
          for (int i = 0; i < 4; ++i) { const int c = 4 * i + kq; const u32x4 v = cv[i];
            const float x0 = (bf_lo(v.x) - sv.x) * sv.y * gam[i][0][0], x1 = (bf_hi(v.x) - sv.x) * sv.y * gam[i][0][1], x2 = (bf_lo(v.y) - sv.x) * sv.y * gam[i][0][2], x3 = (bf_hi(v.y) - sv.x) * sv.y * gam[i][0][3];
            const float x4 = (bf_lo(v.z) - sv.x) * sv.y * gam[i][1][0], x5 = (bf_hi(v.z) - sv.x) * sv.y * gam[i][1][1], x6 = (bf_lo(v.w) - sv.x) * sv.y * gam[i][1][2], x7 = (bf_hi(v.w) - sv.x) * sv.y * gam[i][1][3];
            LAS bf16_t* vp = VT + (8 * c) * SG_LD + (sl ^ ((c & 3) * 16));
            vp[0 * SG_LD] = (bf16_t)f2bf(x0); vp[1 * SG_LD] = (bf16_t)f2bf(x1); vp[2 * SG_LD] = (bf16_t)f2bf(x2); vp[3 * SG_LD] = (bf16_t)f2bf(x3);
            vp[4 * SG_LD] = (bf16_t)f2bf(x4); vp[5 * SG_LD] = (bf16_t)f2bf(x5); vp[6 * SG_LD] = (bf16_t)f2bf(x6); vp[7 * SG_LD] = (bf16_t)f2bf(x7); } }
        __syncthreads();
        f32x4 acc[8];
#pragma unroll
        for (int n = 0; n < 8; ++n) acc[n] = (f32x4){0.f, 0.f, 0.f, 0.f};
        const int nks = (16 * wave + 15) / 32 + 1;
        for (int ks = 0; ks < nks; ++ks) {
            const bf16x8 a = *(const LAS bf16x8*)(WL + (16 * wave + lr) * SG_LD + 32 * ks + 8 * kq);
#pragma unroll
            for (int n = 0; n < 8; ++n) { const int row = 16 * n + lr; const bf16x8 bv = *(const LAS bf16x8*)(VT + row * SG_LD + ((32 * ks + 8 * kq) ^ (((row >> 3) & 3) * 16)));
                acc[n] = __builtin_amdgcn_mfma_f32_16x16x32_bf16(bv, a, acc[n], 0, 0, 0); }
        }
        { const float bs = BS[sl]; bf16_t* up = SU + (tok0 + sl) * 1024 + g * 128 + 4 * kq;
#pragma unroll
            for (int n = 0; n < 8; ++n) { const u32x2 u = uc[n];
                u32x2 o; o.x = cvt_pk_bf16(bf_lo(u.x) * (acc[n][0] + bs), bf_hi(u.x) * (acc[n][1] + bs)); o.y = cvt_pk_bf16(bf_lo(u.y) * (acc[n][2] + bs), bf_hi(u.y) * (acc[n][3] + bs));
                *(u32x2*)(up + 16 * n) = o; } }
    }
#undef SG_LOADS
    __syncthreads();
}

namespace att {
constexpr float SCALE = 0.08838834764831845f, THR = 8.f;
constexpr int NW = 8, QBLK = 32, KVBLK = 64, QB = NW * QBLK, RS = 1024, DH = 128;
constexpr int SHM_V = KVBLK * DH * 2, SHM_K = KVBLK * DH * 2;
constexpr int ATT_LDS = 2 * SHM_V + 2 * SHM_K + NW * 64 * 4;
typedef __attribute__((address_space(4))) const u64 cu64;
#define KSWZ(row, colB) ((row) * 256 + ((colB) ^ (((row) & 7) << 4)))
#define SBAR() __builtin_amdgcn_sched_barrier(0)
__device__ __forceinline__ int v_st(int k, int c) { const int kk = (k & ~0xC) | ((k & 4) << 1) | ((k & 8) >> 1); return ((kk >> 3) * 4 + (c >> 5)) * 512 + ((kk & 7) * 32 + (c & 31)) * 2; }
__device__ __forceinline__ int v_rd_base(int lane) { return ((lane & 3) << 3) | (((lane >> 2) & 3) << 6) | (((lane >> 4) & 1) << 5) | (((lane >> 5) & 1) << 8); }
constexpr int v_rd_off(int d0, int ks, int half) { return d0 * 512 + ks * 4096 + half * 2048; }
__device__ __forceinline__ int crow(int r, int hi) { return (r & 3) + 8 * (r >> 2) + 4 * hi; }
__device__ __forceinline__ unsigned cvtpk(float lo, float hi) { unsigned r; asm volatile("v_cvt_pk_bf16_f32 %0, %1, %2" : "=v"(r) : "v"(lo), "v"(hi)); return r; }
__device__ __forceinline__ bf16x8 load8(const bf16_t* p) { return *reinterpret_cast<const bf16x8*>(p); }
typedef unsigned u32x16 __attribute__((ext_vector_type(16)));
struct MaskHalf { u32x16 a, b; };
__device__ __forceinline__ void msk_issue(MaskHalf& m, const u64* p) {
    asm volatile("s_load_dwordx16 %0, %2, 0x0\n\ts_load_dwordx16 %1, %2, 0x40" : "=&s"(m.a), "=s"(m.b) : "s"(p) : "memory");
}
__device__ __forceinline__ void msk_wait(MaskHalf& m) { asm volatile("s_waitcnt lgkmcnt(0)" : "+s"(m.a), "+s"(m.b) :: "memory"); }
__device__ __forceinline__ void msk_apply(f32x16& p, const MaskHalf& m) {
    const float NEG = -__builtin_inff();
#pragma unroll
    for (int r = 0; r < 16; ++r) { const u64 w = (r < 8) ? (((u64)m.a[2 * r + 1] << 32) | m.a[2 * r]) : (((u64)m.b[2 * (r - 8) + 1] << 32) | m.b[2 * (r - 8)]);
        asm volatile("v_cndmask_b32_e64 %0, %1, %0, %2" : "+v"(p[r]) : "v"(NEG), "s"(w)); }
}
__device__ __forceinline__ void mask_tile(f32x16& p0, f32x16& p1, const u64* mw) {
    asm volatile("s_nop 15\n\ts_nop 15" : "+v"(p0), "+v"(p1));
    MaskHalf m; msk_issue(m, mw); msk_wait(m); msk_apply(p0, m); msk_issue(m, mw + 16); msk_wait(m); msk_apply(p1, m);
}
__device__ __forceinline__ void partialSM(f32x16& p0, f32x16& p1, float& m_reg, float& mn, float& alpha) {
    float pmax = p0[0]; for (int r = 1; r < 16; ++r) pmax = fmaxf(pmax, p0[r]); for (int r = 0; r < 16; ++r) pmax = fmaxf(pmax, p1[r]);
    { auto rr = __builtin_amdgcn_permlane32_swap(__float_as_uint(pmax), __float_as_uint(pmax), false, false);
      pmax = fmaxf(__uint_as_float(rr[0]), __uint_as_float(rr[1])); }
    constexpr float C2 = 1.4426950408889634f * SCALE;
    if (__builtin_expect(__all((pmax - m_reg) * SCALE <= THR), 1)) { mn = m_reg; alpha = 1.f; }
    else { mn = fmaxf(m_reg, pmax); alpha = __builtin_amdgcn_exp2f((m_reg - mn) * C2); m_reg = mn; }
    const float mnL = -mn * C2;
    for (int r = 0; r < 16; ++r) p0[r] = fmaf(p0[r], C2, mnL); for (int r = 0; r < 16; ++r) p1[r] = fmaf(p1[r], C2, mnL);
    for (int r = 0; r < 16; ++r) p0[r] = __builtin_amdgcn_exp2f(p0[r]);
}
__device__ __forceinline__ void finishSM(f32x16& p0, f32x16& p1, float alpha, float& l_reg, bf16x8& pa0, bf16x8& pa1, bf16x8& pa2, bf16x8& pa3) {
    for (int r = 0; r < 16; ++r) p1[r] = __builtin_amdgcn_exp2f(p1[r]);
    float ps = 0; for (int r = 0; r < 16; ++r) ps += p0[r]; for (int r = 0; r < 16; ++r) ps += p1[r];
    { auto rr = __builtin_amdgcn_permlane32_swap(__float_as_uint(ps), __float_as_uint(ps), false, false);
      ps = __uint_as_float(rr[0]) + __uint_as_float(rr[1]); }
    l_reg = l_reg * alpha + ps;
#define PK4(P, B_, OUT) do { unsigned a0 = cvtpk(P[B_+0], P[B_+1]), a1 = cvtpk(P[B_+2], P[B_+3]);                          \
        unsigned b0 = cvtpk(P[B_+4], P[B_+5]), b1 = cvtpk(P[B_+6], P[B_+7]);                                             \
        auto r0 = __builtin_amdgcn_permlane32_swap(a0, b0, false, false); auto r1 = __builtin_amdgcn_permlane32_swap(a1, b1, false, false); \
        u32x4 w = {r0[0], r1[0], r0[1], r1[1]}; OUT = *reinterpret_cast<bf16x8*>(&w); } while (0)
    PK4(p0, 0, pa0); PK4(p0, 8, pa1); PK4(p1, 0, pa2); PK4(p1, 8, pa3);
#undef PK4
}
template <int KB>
__device__ __forceinline__ void qkt(f32x16& p0, f32x16& p1, const char* K_lds, int r32, int hi, const bf16x8* qr) {
    p0 = f32x16{}; p1 = f32x16{};
    const char* kb[4];
#pragma unroll
    for (int dd = 0; dd < 4; ++dd) kb[dd] = K_lds + KB * SHM_K + KSWZ(r32, (dd * 16 + hi * 8) * 2);
#pragma unroll
    for (int d0 = 0; d0 < 8; ++d0) { const char* a = kb[d0 & 3] + (d0 >> 2) * 128;
        bf16x8 b0 = *reinterpret_cast<const bf16x8*>(a);
        bf16x8 b1 = *reinterpret_cast<const bf16x8*>(a + 32 * 256);
        p0 = __builtin_amdgcn_mfma_f32_32x32x16_bf16(b0, qr[d0], p0, 0, 0, 0);
        p1 = __builtin_amdgcn_mfma_f32_32x32x16_bf16(b1, qr[d0], p1, 0, 0, 0); }
}
#define TRRD(dst, off) asm volatile("ds_read_b64_tr_b16 %0, %1 offset:%2" : "=&v"(dst) : "v"(vb0), "i"(off) : "memory")
#define PV_D0(d0) do { s16x4 l0, l1, l2, l3, h0, h1, h2, h3; constexpr int b_ = VB * SHM_V + v_rd_off(d0, 0, 0); \
        TRRD(l0, b_); TRRD(h0, b_ + 2048); TRRD(l1, b_ + 4096); TRRD(h1, b_ + 6144); TRRD(l2, b_ + 8192); TRRD(h2, b_ + 10240); TRRD(l3, b_ + 12288); TRRD(h3, b_ + 14336); \
        asm volatile("s_waitcnt lgkmcnt(0)" ::: "memory"); SBAR();   \
        o[d0] = __builtin_amdgcn_mfma_f32_32x32x16_bf16(pa0, (bf16x8){l0[0], l0[1], l0[2], l0[3], h0[0], h0[1], h0[2], h0[3]}, o[d0], 0, 0, 0);   \
        o[d0] = __builtin_amdgcn_mfma_f32_32x32x16_bf16(pa1, (bf16x8){l1[0], l1[1], l1[2], l1[3], h1[0], h1[1], h1[2], h1[3]}, o[d0], 0, 0, 0);   \
        o[d0] = __builtin_amdgcn_mfma_f32_32x32x16_bf16(pa2, (bf16x8){l2[0], l2[1], l2[2], l2[3], h2[0], h2[1], h2[2], h2[3]}, o[d0], 0, 0, 0);   \
        o[d0] = __builtin_amdgcn_mfma_f32_32x32x16_bf16(pa3, (bf16x8){l3[0], l3[1], l3[2], l3[3], h3[0], h3[1], h3[2], h3[3]}, o[d0], 0, 0, 0); } while (0)
template <int VB>
__device__ __forceinline__ void pv_tile(f32x16* o, int vb0, bf16x8 pa0, bf16x8 pa1, bf16x8 pa2, bf16x8 pa3) {
    PV_D0(0); PV_D0(1); PV_D0(2); PV_D0(3);
}
template <int VB>
__device__ __forceinline__ void pv_tile_mask(f32x16* o, int vb0, bf16x8 pa0, bf16x8 pa1, bf16x8 pa2, bf16x8 pa3, f32x16& x0, f32x16& x1, const u64* mw) {
    MaskHalf m; msk_issue(m, mw);
    PV_D0(0); PV_D0(1);
    msk_wait(m); msk_apply(x0, m); SBAR();
    msk_issue(m, mw + 16);
    PV_D0(2); PV_D0(3);
    msk_wait(m); msk_apply(x1, m); SBAR();
}
#undef PV_D0
#undef TRRD
struct BlockRef { const bf16_t* Q; const bf16_t* K; const bf16_t* V; bf16_t* O; const u64* MW; int P0; };
struct Seam { bf16x8 qr[8]; bf16x8 st_v0, st_v1, st_k0, st_k1; };
#define ROW(p, k0, rr) ((p) + (size_t)((k0) + (rr)) * RS + sc)
#define VMW() asm volatile("s_waitcnt vmcnt(0)" ::: "memory")
#define VMWN(n) asm volatile("s_waitcnt vmcnt(%0)" :: "i"(n) : "memory")
#define SLOAD_H(Kp, Vp, k0) do { S.st_v0 = load8(ROW(Vp, k0, sr)); S.st_v1 = load8(ROW(Vp, k0, 32 + sr));              \
                         S.st_k0 = load8(ROW(Kp, k0, sr)); S.st_k1 = load8(ROW(Kp, k0, 32 + sr)); } while (0)
#define SWRITE_HK(bf) do { *(bf16x8*)(K_lds + (bf) * SHM_K + kws) = S.st_k0; *(bf16x8*)(K_lds + (bf) * SHM_K + kws + 32 * 256) = S.st_k1; } while (0)
#define SWRITE_HV(bf) do { *(bf16x8*)(V_lds + (bf) * SHM_V + vst0) = S.st_v0; *(bf16x8*)(V_lds + (bf) * SHM_V + vst1) = S.st_v1; } while (0)
#define SWRITE_H(bf) do { SWRITE_HV(bf); SWRITE_HK(bf); } while (0)
__device__ __forceinline__ void prime(const BlockRef& cur, char* lds, Seam& S) {
    const int tid = threadIdx.x, wid = __builtin_amdgcn_readfirstlane(tid >> 6), lane = tid & 63, r32 = lane & 31, hi = lane >> 5;
    const int sr = tid >> 4, sc = (tid & 15) * 8, kws = KSWZ(sr, sc * 2); char* K_lds = lds + 2 * SHM_V;
    for (int d0 = 0; d0 < 8; ++d0) S.qr[d0] = load8(cur.Q + (size_t)(wid * QBLK + r32) * RS + d0 * 16 + hi * 8);
    SLOAD_H(cur.K, cur.V, 0); VMW(); SWRITE_HK(0);
    __syncthreads();
}
__device__ __forceinline__ void block(const BlockRef& cur, const BlockRef& nxt, char* lds, Seam& S) {
    const int tid = threadIdx.x, wid = __builtin_amdgcn_readfirstlane(tid >> 6), lane = tid & 63, r32 = lane & 31, hi = lane >> 5;
    const int NT = (cur.P0 + QB - 1) / KVBLK + 1;
    char* V_lds = lds; char* K_lds = lds + 2 * SHM_V;
    float* ws = (float*)(lds + 2 * SHM_V + 2 * SHM_K) + wid * 64; float* li_l = ws, * al_l = ws + 32;
    float m_reg = -1e30f, l_reg = 0; f32x16 o[4] = {};
    const int sr = tid >> 4, sc = (tid & 15) * 8, vst0 = v_st(sr, sc), vst1 = v_st(32 + sr, sc), kws = KSWZ(sr, sc * 2);
    const int vb0 = (int)(uintptr_t)V_lds + v_rd_base(lane);
    const bf16_t* Kh = cur.K; const bf16_t* Vh = cur.V;
    const u64* mwb = cur.MW + (size_t)wid * (64 * 32);
#define RESC(a) do { if (__any((a) < 1.f)) { if (hi == 0) al_l[r32] = (a); asm volatile("s_waitcnt lgkmcnt(0)" ::: "memory");              \
                     for (int d_ = 0; d_ < 4; ++d_) for (int r = 0; r < 16; ++r) o[d_][r] *= al_l[crow(r, hi)]; } } while (0)
#define KBASE(t) ((t) * KVBLK)
#define MASKT(P0_, P1_, t) mask_tile(P0_, P1_, mwb + (size_t)(t) * 32)
    constexpr int NQL = 8;
#define SEAM_K0() do { VMWN(NQL); SWRITE_HK(0); SBAR(); } while (0)
    f32x16 pA0, pA1, pB0, pB1; float mnA, mnB, alA, alB; bf16x8 pa0, pa1, pa2, pa3;
    SWRITE_HV(0); SBAR();
    if (NT > 1) { SLOAD_H(Kh, Vh, KBASE(1)); }
    SBAR(); qkt<0>(pA0, pA1, K_lds, r32, hi, S.qr);
    MASKT(pA0, pA1, 0); partialSM(pA0, pA1, m_reg, mnA, alA);
    if (NT > 1) { VMW(); SWRITE_H(1); }
    __syncthreads();
#define HALF_STEP(PX0, PX1, mnX, alX, PY0, PY1, alY, t, KB, VB, SB) do {                                                      \
        SBAR(); qkt<KB>(PX0, PX1, K_lds, r32, hi, S.qr);                                             \
        finishSM(PY0, PY1, alY, l_reg, pa0, pa1, pa2, pa3); SBAR();                                                           \
        if ((t) + 1 < NT) { SLOAD_H(Kh, Vh, KBASE((t) + 1)); SBAR(); }                                               \
        pv_tile_mask<VB>(o, vb0, pa0, pa1, pa2, pa3, PX0, PX1, mwb + (size_t)(t) * 32); partialSM(PX0, PX1, m_reg, mnX, alX);                                        \
        __syncthreads();                                                                                                      \
        if ((t) + 1 < NT) { VMW(); SWRITE_H(SB); }                                                                          \
        RESC(alX); __syncthreads(); } while (0)
    for (int t = 1; t + 1 < NT; t += 2) {
        HALF_STEP(pB0, pB1, mnB, alB, pA0, pA1, alA, t, 1, 0, 0);
        HALF_STEP(pA0, pA1, mnA, alA, pB0, pB1, alB, t + 1, 0, 1, 1);
    }
    const bool even = (NT & 1) == 0;
    if (even) { SBAR(); qkt<1>(pB0, pB1, K_lds, r32, hi, S.qr); SBAR(); }
    SLOAD_H(nxt.K, nxt.V, 0); SBAR();
#pragma unroll
    for (int d0 = 0; d0 < 8; ++d0) S.qr[d0] = load8(nxt.Q + (size_t)(wid * QBLK + r32) * RS + d0 * 16 + hi * 8);
    SBAR();
    finishSM(pA0, pA1, alA, l_reg, pa0, pa1, pa2, pa3); SBAR();
    pv_tile<0>(o, vb0, pa0, pa1, pa2, pa3);
    if (even) { MASKT(pB0, pB1, NT - 1); partialSM(pB0, pB1, m_reg, mnB, alB); __syncthreads(); RESC(alB);
        finishSM(pB0, pB1, alB, l_reg, pa0, pa1, pa2, pa3); SBAR(); pv_tile<1>(o, vb0, pa0, pa1, pa2, pa3); }
    SBAR(); SEAM_K0();
    if (hi == 0) li_l[r32] = l_reg; asm volatile("s_waitcnt lgkmcnt(0)" ::: "memory");
    float rli[16];
#pragma unroll
    for (int r = 0; r < 16; ++r) rli[r] = __builtin_amdgcn_rcpf(li_l[crow(r, hi)]);
    bf16_t* Ow = cur.O + (size_t)(wid * QBLK) * RS;
#pragma unroll
    for (int r = 0; r < 16; ++r) { const int orow = crow(r, hi);
#pragma unroll
        for (int d0 = 0; d0 < 4; ++d0) { const float v = o[d0][r] * rli[r];
            const float vn = __shfl_xor(v, 1);
            if ((r32 & 1) == 0) *(unsigned*)(Ow + (size_t)orow * RS + d0 * 32 + r32) = cvtpk(v, vn); } }
    __syncthreads();
#undef RESC
#undef KBASE
#undef MASKT
#undef SEAM_K0
#undef HALF_STEP
}
#undef ROW
#undef VMW
#undef VMWN
#undef SLOAD_H
#undef SWRITE_HK
#undef SWRITE_HV
#undef SWRITE_H
#undef KSWZ
#undef SBAR
}

__device__ __forceinline__ att::BlockRef att_ref(Frame& F, int bh, int qb, size_t obase = WS_Q) {
    const int b = bh >> 3, h = bh & 7; att::BlockRef r;
    bf16_t* Qb = (bf16_t*)(F.ws + WS_Q); const bf16_t* Kb = (const bf16_t*)(F.ws + WS_K); const bf16_t* Vb = (const bf16_t*)(F.ws + WS_V);
    r.Q = Qb + ((size_t)b * SEQ + (size_t)qb * 256) * 1024 + h * 128; r.O = (bf16_t*)(F.ws + obase) + ((size_t)b * SEQ + (size_t)qb * 256) * 1024 + h * 128;
    r.K = Kb + (size_t)b * SEQ * 1024 + h * 128; r.V = Vb + (size_t)b * SEQ * 1024 + h * 128;
    r.MW = (const u64*)(F.ws + WS_MASK) + ((size_t)(b * 128 + qb * 8) * 64) * 32; r.P0 = qb * 256;
    return r;
}
__device__ __forceinline__ void p3_attn(const Args& A, Frame& F, size_t obase = WS_Q) {
    const int G = F.G; int L, stride, limit;
    if (G % 8 == 0) { L = (F.bx & 7) * 64 + (F.bx >> 3); stride = G >> 3; limit = (F.bx & 7) * 64 + 64; } else { L = F.bx; stride = G; limit = 512; }
    if (L >= limit) return;
    int pass = 0;
    att::BlockRef cur = att_ref(F, L >> 3, L & 7, obase);
    att::Seam S;
    att::prime(cur, (char*)F.lds, S);
    for (;;) {
        const bool more_pass = pass == 0, more_item = L + stride < limit, last = !more_pass && !more_item;
        int passn = pass + 1, Ln = L;
        if (!more_pass) { passn = 0; Ln = more_item ? L + stride : L; }
        const att::BlockRef nxt = last ? cur : att_ref(F, Ln >> 3, passn ? 15 - (Ln & 7) : (Ln & 7), obase);
        att::block(cur, nxt, (char*)F.lds, S);
        if (last) break;
        cur = nxt; pass = passn; L = Ln;
    }
}

struct SchedTwo {
    const char* A0; const char* B0; const char* A1; const char* B1; int nM, nN, G, c; size_t tstep;
    __device__ __forceinline__ bool next(int i, pg8::Seg& s) const {
        int pm, pn; if (!pg8::static_tile(i >> 1, G, c, nM, nN, pm, pn)) return false;
        s.pm = pm; s.pn = pn; s.aux = 0;
        if ((i & 1) == 0) { s.A = A0 + (size_t)pm * tstep; s.B = B0 + (size_t)pn * tstep; s.kind = 1; }
        else { s.A = A1 + (size_t)pm * tstep; s.B = B1 + (size_t)pn * tstep; s.kind = 2; }
        return true;
    }
    __device__ __forceinline__ int row(const pg8::Seg&, int) const { return 0; }
};
struct EpiMerge {
    static constexpr bool PERM = true;
    const bf16_t* sga; const bf16_t* sgb; bf16_t* mg;
    __device__ __forceinline__ void mid(f32x4 (&acc)[2][2][4][2], const pg8::Seg& u, int wr, int wc, int fr, int fq) const {
        const int row0 = u.pm * 256 + wr * 64 + fr, col0 = u.pn * 256 + wc * 32 + 8 * fq;
#pragma unroll
        for (int ai = 0; ai < 2; ++ai)
#pragma unroll
            for (int m = 0; m < 4; ++m)
#pragma unroll
                for (int bj = 0; bj < 2; ++bj) { const size_t off = (size_t)(row0 + ai * 128 + m * 16) * 1024 + col0 + bj * 128;
                    const u32x4 a = *(const u32x4*)(sga + off), b = *(const u32x4*)(sgb + off);
                    const unsigned aw[4] = {a.x, a.y, a.z, a.w}, bw[4] = {b.x, b.y, b.z, b.w};
#pragma unroll
                    for (int j = 0; j < 4; ++j) { const float r0 = bf_lo(aw[j]) * __builtin_amdgcn_rcpf(fmaxf(bf_lo(bw[j]), 1e-30f)), r1 = bf_hi(aw[j]) * __builtin_amdgcn_rcpf(fmaxf(bf_hi(bw[j]), 1e-30f));
                        acc[ai][bj][m][j >> 1][(j & 1) * 2] *= r0; acc[ai][bj][m][j >> 1][(j & 1) * 2 + 1] *= r1; } }
    }
    __device__ __forceinline__ void operator()(f32x4 (&acc)[2][2][4][2], const pg8::Seg& u, int wr, int wc, int fr, int fq) const {
        const int row0 = u.pm * 256 + wr * 64 + fr, col0 = u.pn * 256 + wc * 32 + 8 * fq;
#pragma unroll
        for (int ai = 0; ai < 2; ++ai)
#pragma unroll
            for (int m = 0; m < 4; ++m)
#pragma unroll
                for (int bj = 0; bj < 2; ++bj) { const size_t off = (size_t)(row0 + ai * 128 + m * 16) * 1024 + col0 + bj * 128;
                    const u32x4 b = *(const u32x4*)(sgb + off); const unsigned bw[4] = {b.x, b.y, b.z, b.w};
                    f32x4 v0 = acc[ai][bj][m][0], v1 = acc[ai][bj][m][1];
                    v0[0] *= fmaxf(bf_lo(bw[0]), 1e-30f); v0[1] *= fmaxf(bf_hi(bw[0]), 1e-30f); v0[2] *= fmaxf(bf_lo(bw[1]), 1e-30f); v0[3] *= fmaxf(bf_hi(bw[1]), 1e-30f);
                    v1[0] *= fmaxf(bf_lo(bw[2]), 1e-30f); v1[1] *= fmaxf(bf_hi(bw[2]), 1e-30f); v1[2] *= fmaxf(bf_lo(bw[3]), 1e-30f); v1[3] *= fmaxf(bf_hi(bw[3]), 1e-30f);
                    *(u32x4*)(mg + off) = pack8v(v0, v1); }
    }
};
__device__ __forceinline__ void p4a_merge(const Args& A, Frame& F) {
    SchedTwo S; S.A0 = (const char*)(F.ws + WS_SU); S.B0 = (const char*)(F.ws + WS_WA); S.A1 = (const char*)(F.ws + WS_Q); S.B1 = (const char*)(F.ws + WS_WB);
    S.nM = T / 256; S.nN = D / 256; S.G = F.G; S.c = F.bx; S.tstep = (size_t)256 * D * 2;
    EpiMerge E; E.sga = (const bf16_t*)F.out; E.sgb = (const bf16_t*)((unsigned char*)F.out + 64 * MiB); E.mg = (bf16_t*)(F.ws + WS_MG);
    pg8::gemm_phase<EpiMerge, SchedTwo, false>(F.lds, S, E, D, D, D / 64);
}

struct EpiRes {
    static constexpr bool PERM = true;
    const float* x; bf16_t* h1;
    __device__ __forceinline__ void mid(f32x4 (&)[2][2][4][2], const pg8::Seg&, int, int, int, int) const {}
    __device__ __forceinline__ void operator()(f32x4 (&acc)[2][2][4][2], const pg8::Seg& u, int wr, int wc, int fr, int fq) const {
        const int row0 = u.pm * 256 + wr * 64 + fr, col0 = u.pn * 256 + wc * 32 + 8 * fq;
#pragma unroll
        for (int ai = 0; ai < 2; ++ai)
#pragma unroll
            for (int m = 0; m < 4; ++m)
#pragma unroll
                for (int bj = 0; bj < 2; ++bj) { const size_t off = (size_t)(row0 + ai * 128 + m * 16) * 1024 + col0 + bj * 128;
                    const f32x4 x0 = *(const f32x4*)(x + off), x1 = *(const f32x4*)(x + off + 4);
                    *(u32x4*)(h1 + off) = pack8v(x0 + acc[ai][bj][m][0], x1 + acc[ai][bj][m][1]); }
    }
};
__device__ __forceinline__ void p4b_out(const Args& A, Frame& F) {
    SchedDense S; S.A = (const char*)(F.ws + WS_MG); S.B = (const char*)(F.ws + WS_WO); S.nM = T / 256; S.nN = D / 256; S.G = F.G; S.c = F.bx; S.tstepA = (size_t)256 * D * 2; S.tstepB = (size_t)256 * D * 2;
    EpiRes E; E.x = ((const float*)A.in[0]); E.h1 = (bf16_t*)(F.ws + WS_H1);
    pg8::gemm_phase<EpiRes, SchedDense, false>(F.lds, S, E, D, D, D / 64);
}

constexpr int P5_WH = 0, P5_WP = 2064, P5_WL = 36 * P5_WP, P5_RT = 2 * 36 * P5_WP, P5_CNT = P5_RT + 2048, P5_LOG = 0, P5_WC = P5_CNT + 512, P5_G2 = P5_WC + 512;
__device__ __forceinline__ void p5_route(const Args& A, Frame& F) {
    LAS unsigned char* lds = F.lds; const int tid = F.tid, lane = F.lane, wave = F.wave;
#ifdef P5_DUP_A
    for (int rep = 0; rep < 2; ++rep)
#endif
    {
        LAS float* scr = (LAS float*)(lds + wave * 16384);
        const int gw = F.bx * NWAVES + wave, NGW = F.G * NWAVES;
        bf16_t* WEI = (bf16_t*)(F.ws + WS_WEIN); bf16_t* WEO = (bf16_t*)(F.ws + WS_WEOUT);
        constexpr int I_IN = (D / 64) * (512 / 32), I_OUT = (DEXP / 64) * (D / 32);
        for (int it = gw; it < NEXP * (I_IN + I_OUT); it += NGW) {
            if (it < NEXP * I_IN) { const int e = it / I_IN, r = it % I_IN; transpose_item<2>(((const float*)A.in[15]) + (size_t)e * D * 512, D, 512, 512, WEI + (size_t)e * 512 * D, scr, r, lane); }
            else { const int q = it - NEXP * I_IN, e = q / I_OUT, r = q % I_OUT; transpose_item<0>(((const float*)A.in[16]) + (size_t)e * DEXP * D, DEXP, D, D, WEO + (size_t)e * D * DEXP, scr, r, lane); }
        }
    }
    __syncthreads();
    LAS int* RTe = (LAS int*)(lds + P5_RT); LAS float* RTg = (LAS float*)(lds + P5_RT + 1024); LAS int* LC = (LAS int*)(lds + P5_CNT); LAS int* WC = (LAS int*)(lds + P5_WC);
    bf16_t* XN2 = (bf16_t*)(F.ws + WS_XN2); unsigned* LIST = (unsigned*)(F.ws + WS_LIST); unsigned* ECNT = (unsigned*)(F.ws + WS_CTL) + CW_ECNT; float* GATE = (float*)(F.ws + WS_GATE); float* RSTD = (float*)(F.ws + WS_RSTD);
    for (int rb = F.bx; rb < T / 128; rb += F.G) {
        for (int i = tid; i < 72 * 128; i += 512) { const int c = i >> 7, off = (i & 127) * 16;
            const u32x4 v = *(const u32x4*)((const unsigned char*)(F.ws + WS_WRT) + (size_t)i * 16);
            *(LAS u32x4*)(lds + (c < 36 ? P5_WH + c * P5_WP : P5_WL + (c - 36) * P5_WP) + off) = v; }
        if (tid < 256) *(LAS f32x4*)(lds + P5_G2 + tid * 16) = *(const f32x4*)(((const float*)A.in[10]) + tid * 4);
        __syncthreads();
        const int lr = lane & 15, kq = lane >> 4; const size_t row = (size_t)rb * 128 + 16 * wave + lr;
        f32x4 acc[3]; acc[0] = (f32x4){0.f, 0.f, 0.f, 0.f}; acc[1] = acc[0]; acc[2] = acc[0]; float ss = 0.f;
#ifdef P5_DUP_ROWS
        for (int rep = 0; rep < 2; ++rep)
#endif
        {
        const bf16_t* hrow = (const bf16_t*)(F.ws + WS_H1) + row * D + 8 * kq; const LAS unsigned char* g2l = lds + P5_G2 + 32 * kq; bf16_t* xrow = XN2 + row * D + 8 * kq;
        const int n2 = (32 + lr) > 35 ? 35 : (32 + lr);
        const LAS unsigned char* bh0 = lds + P5_WH + lr * P5_WP + 16 * kq; const LAS unsigned char* bh1 = bh0 + 16 * P5_WP; const LAS unsigned char* bh2 = lds + P5_WH + n2 * P5_WP + 16 * kq;
#pragma unroll 1
        for (int hf = 0; hf < 2; ++hf) {
            u32x4 hq[16];
#pragma unroll
            for (int i = 0; i < 16; ++i) hq[i] = *(const u32x4*)(hrow + 32 * (16 * hf + i));
#pragma unroll
            for (int i = 0; i < 16; ++i) { const int ks = 16 * hf + i; const u32x4 hw = hq[i];
                const f32x4 g0 = *(const LAS f32x4*)(g2l + 128 * ks), g1 = *(const LAS f32x4*)(g2l + 128 * ks + 16);
                const f32x4 h0 = {bf_lo(hw.x), bf_hi(hw.x), bf_lo(hw.y), bf_hi(hw.y)}, h1 = {bf_lo(hw.z), bf_hi(hw.z), bf_lo(hw.w), bf_hi(hw.w)};
                ss += (h0.x * h0.x + h0.y * h0.y) + (h0.z * h0.z + h0.w * h0.w) + (h1.x * h1.x + h1.y * h1.y) + (h1.z * h1.z + h1.w * h1.w);
                *(u32x4*)(xrow + 32 * ks) = pack8v(h0 * g0, h1 * g1);
                const bf16x8 ahi = __builtin_bit_cast(bf16x8, hw);
                { const bf16x8 wh = *(const LAS bf16x8*)(bh0 + 64 * ks), wl = *(const LAS bf16x8*)(bh0 + 64 * ks + P5_WL);
                  acc[0] = __builtin_amdgcn_mfma_f32_16x16x32_bf16(ahi, wh, acc[0], 0, 0, 0); acc[0] = __builtin_amdgcn_mfma_f32_16x16x32_bf16(ahi, wl, acc[0], 0, 0, 0); }
                { const bf16x8 wh = *(const LAS bf16x8*)(bh1 + 64 * ks), wl = *(const LAS bf16x8*)(bh1 + 64 * ks + P5_WL);
                  acc[1] = __builtin_amdgcn_mfma_f32_16x16x32_bf16(ahi, wh, acc[1], 0, 0, 0); acc[1] = __builtin_amdgcn_mfma_f32_16x16x32_bf16(ahi, wl, acc[1], 0, 0, 0); }
                { const bf16x8 wh = *(const LAS bf16x8*)(bh2 + 64 * ks), wl = *(const LAS bf16x8*)(bh2 + 64 * ks + P5_WL);
                  acc[2] = __builtin_amdgcn_mfma_f32_16x16x32_bf16(ahi, wh, acc[2], 0, 0, 0); acc[2] = __builtin_amdgcn_mfma_f32_16x16x32_bf16(ahi, wl, acc[2], 0, 0, 0); }
            }
        }
        }
#ifdef P5_DUP_ROWS
        ss *= 0.5f; acc[0] = acc[0] * 0.5f; acc[1] = acc[1] * 0.5f; acc[2] = acc[2] * 0.5f;
#endif
        ss += __shfl_xor(ss, 16); ss += __shfl_xor(ss, 32);
        const float rstd = 1.0f / sqrtf(ss * (1.f / D) + EPS);
        if (kq == 0) RSTD[row] = rstd;
        __syncthreads();
        LAS float* LOG = (LAS float*)(lds + P5_LOG) + wave * (16 * 48);
#pragma unroll
        for (int ct = 0; ct < 3; ++ct)
#pragma unroll
            for (int r = 0; r < 4; ++r) LOG[(4 * kq + r) * 48 + 16 * ct + lr] = acc[ct][r];
        LDS_WAIT();
        if (lane < 16) {
            float lg[36];
#pragma unroll
            for (int c = 0; c < 36; c += 4) { const f32x4 t = *(const LAS f32x4*)(LOG + lane * 48 + c); lg[c] = t.x; lg[c + 1] = t.y; lg[c + 2] = t.z; lg[c + 3] = t.w; }
#pragma unroll
            for (int c = 0; c < 36; ++c) lg[c] = lg[c] * rstd + ((c < 4) ? ((const float*)A.in[12])[c] : ((const float*)A.in[14])[c - 4]);
            int gs = 0; float gm = lg[0];
#pragma unroll
            for (int c = 1; c < 4; ++c) if (lg[c] > gm) { gm = lg[c]; gs = c; }
            float den = 0.f;
#pragma unroll
            for (int c = 0; c < 4; ++c) den += __expf(lg[c] - gm);
            const float gprob = 1.0f / den;
            float el[8];
#pragma unroll
            for (int i = 0; i < 8; ++i) { el[i] = lg[4 + i];
#pragma unroll
                for (int g = 1; g < 4; ++g) el[i] = (gs == g) ? lg[4 + 8 * g + i] : el[i]; }
            int i1 = 0; float v1 = el[0];
#pragma unroll
            for (int i = 1; i < 8; ++i) if (el[i] > v1) { v1 = el[i]; i1 = i; }
            int i2 = -1; float v2 = -__builtin_inff();
#pragma unroll
            for (int i = 0; i < 8; ++i) if (i != i1 && (i2 < 0 || el[i] > v2)) { v2 = el[i]; i2 = i; }
            const float p2 = 1.0f / (1.0f + __expf(v1 - v2)), p1 = 1.0f - p2; const int lrow = 16 * wave + lane;
            RTe[2 * lrow] = gs * 8 + i1; RTe[2 * lrow + 1] = gs * 8 + i2; RTg[2 * lrow] = gprob * p1; RTg[2 * lrow + 1] = gprob * p2;
        }
        __syncthreads();
        int e = 0, rank = 0;
        if (tid < 256) { e = RTe[tid];
            for (int ee = 0; ee < 32; ++ee) { const u64 m = __ballot(e == ee); if (lane == 0) WC[wave * 32 + ee] = __builtin_popcountll(m);
                if (e == ee) rank = (int)__builtin_amdgcn_mbcnt_hi((unsigned)(m >> 32), __builtin_amdgcn_mbcnt_lo((unsigned)m, 0u)); } }
        __syncthreads();
        if (tid < 32) { const int c = WC[tid] + WC[32 + tid] + WC[64 + tid] + WC[96 + tid];
            LC[tid] = c ? (int)__hip_atomic_fetch_add(ECNT + tid, (unsigned)c, __ATOMIC_RELAXED, __HIP_MEMORY_SCOPE_AGENT) : 0; }
        __syncthreads();
        if (tid < 256) { int lo = LC[e];
            for (int w = 0; w < 4; ++w) lo += (w < wave) ? WC[w * 32 + e] : 0;
            const unsigned ts = (unsigned)(rb * 128 + (tid >> 1)) * 2u + (tid & 1);
            LIST[(size_t)e * T + lo + rank] = ts; GATE[ts] = RTg[tid]; }
        __syncthreads();
    }
}
constexpr int P6_TAB = 131072;
struct SchedMoe1 {
    const LAS int* tab; const char* xn2; const char* wein; const unsigned* list; int G, c;
    __device__ __forceinline__ bool next(int i, pg8::Seg& s) const {
        const int ntot = tab[32]; const long u = (long)i * G + c; if (u >= 2L * ntot) return false;
        const int gt = (int)(u >> 1), pn = (int)(u & 1); int e = 0;
        for (int k = 1; k < 32; ++k) e += (tab[k] <= gt) ? 1 : 0;
        s.pm = gt; s.pn = pn; s.aux = (e << 16) | (gt - tab[e]); s.kind = 3; s.A = xn2; s.B = wein + ((size_t)e * 512 + pn * 256) * D * 2; return true;
    }
    __device__ __forceinline__ int row(const pg8::Seg& s, int R) const {
        const int e = s.aux >> 16, idx = (s.aux & 0xffff) * 256 + R; const int cnt = tab[33 + e];
        return idx < cnt ? (int)(list[(size_t)e * T + idx] >> 1) : 0;
    }
};
struct EpiAct {
    static constexpr bool PERM = true;
    bf16_t* act; const LAS int* tab; const unsigned* list; const float* rstd;
    __device__ __forceinline__ void mid(f32x4 (&)[2][2][4][2], const pg8::Seg&, int, int, int, int) const {}
    __device__ __forceinline__ void operator()(f32x4 (&acc)[2][2][4][2], const pg8::Seg& u, int wr, int wc, int fr, int fq) const {
        const int row0 = u.pm * 256 + wr * 64 + fr, col0 = u.pn * 128 + wc * 32 + 8 * fq;
#pragma unroll
        for (int ai = 0; ai < 2; ++ai)
#pragma unroll
            for (int m = 0; m < 4; ++m) { f32x4 o0, o1;
                const int e = u.aux >> 16, idx = (u.aux & 0xffff) * 256 + ai * 128 + wr * 64 + m * 16 + fr;
                const float rs = (idx < tab[33 + e]) ? rstd[list[(size_t)e * T + idx] >> 1] : 0.f;
#pragma unroll
                for (int j = 0; j < 4; ++j) { const float g0 = acc[ai][0][m][0][j] * rs, g1 = acc[ai][0][m][1][j] * rs;
                    o0[j] = g0 * fast_sigmoid(g0) * (acc[ai][1][m][0][j] * rs); o1[j] = g1 * fast_sigmoid(g1) * (acc[ai][1][m][1][j] * rs); }
                *(u32x4*)(act + (size_t)(row0 + ai * 128 + m * 16) * DEXP + col0) = pack8v(o0, o1); }
    }
};
struct SchedMoe2 {
    const LAS int* tab; const char* act; const char* weout; int G, c;
    __device__ __forceinline__ bool next(int i, pg8::Seg& s) const {
        const int ntot = tab[32]; const long u = (long)i * G + c; if (u >= 4L * ntot) return false;
        const int gt = (int)(u >> 2), pn = (int)(u & 3); int e = 0;
        for (int k = 1; k < 32; ++k) e += (tab[k] <= gt) ? 1 : 0;
        s.pm = gt; s.pn = pn; s.aux = (e << 16) | (gt - tab[e]); s.kind = 3; s.A = act + (size_t)gt * 256 * DEXP * 2; s.B = weout + ((size_t)e * D + pn * 256) * DEXP * 2; return true;
    }
    __device__ __forceinline__ int row(const pg8::Seg&, int) const { return 0; }
};
struct EpiMoeOut {
    static constexpr bool PERM = true;
    const LAS int* tab; const unsigned* list; const float* gate; bf16_t* ym;
    __device__ __forceinline__ void mid(f32x4 (&)[2][2][4][2], const pg8::Seg&, int, int, int, int) const {}
    __device__ __forceinline__ void operator()(f32x4 (&acc)[2][2][4][2], const pg8::Seg& u, int wr, int wc, int fr, int fq) const {
        const int e = u.aux >> 16, rtl = u.aux & 0xffff, cnt = tab[33 + e], col0 = u.pn * 256 + wc * 32 + 8 * fq;
#pragma unroll
        for (int ai = 0; ai < 2; ++ai)
#pragma unroll
            for (int m = 0; m < 4; ++m) { const int idx = rtl * 256 + ai * 128 + wr * 64 + m * 16 + fr;
                if (idx < cnt) { const unsigned ts = list[(size_t)e * T + idx]; const float g = gate[ts];
#pragma unroll
                    for (int bj = 0; bj < 2; ++bj) *(u32x4*)(ym + (size_t)ts * D + col0 + bj * 128) = pack8v(acc[ai][bj][m][0] * g, acc[ai][bj][m][1] * g); }
                asm volatile("" ::: "memory"); }
    }
};
__device__ __forceinline__ void p6_tables(const Args& A, Frame& F) {
    LAS int* tab = (LAS int*)(F.lds + P6_TAB);
    if (F.tid == 0) { const unsigned* ECNT = (const unsigned*)(F.ws + WS_CTL) + CW_ECNT; int acc = 0;
        for (int e = 0; e < 32; ++e) { const int c = (int)__hip_atomic_load(ECNT + e, __ATOMIC_RELAXED, __HIP_MEMORY_SCOPE_AGENT); tab[e] = acc; tab[33 + e] = c; acc += (c + 255) >> 8; }
        tab[32] = acc; }
    __syncthreads();
}
__device__ __forceinline__ void p6a_moe_in(const Args& A, Frame& F) {
    p6_tables(A, F);
    SchedMoe1 S; S.tab = (const LAS int*)(F.lds + P6_TAB); S.xn2 = (const char*)(F.ws + WS_XN2); S.wein = (const char*)(F.ws + WS_WEIN); S.list = (const unsigned*)(F.ws + WS_LIST); S.G = F.G; S.c = F.bx;
    EpiAct E; E.act = (bf16_t*)(F.ws + WS_ACT); E.tab = S.tab; E.list = S.list; E.rstd = (const float*)(F.ws + WS_RSTD);
    pg8::gemm_phase<EpiAct, SchedMoe1, true>(F.lds, S, E, D, D, D / 64);
}
__device__ __forceinline__ void p6b_moe_out(const Args& A, Frame& F) {
    p6_tables(A, F);
    SchedMoe2 S; S.tab = (const LAS int*)(F.lds + P6_TAB); S.act = (const char*)(F.ws + WS_ACT); S.weout = (const char*)(F.ws + WS_WEOUT); S.G = F.G; S.c = F.bx;
    EpiMoeOut E; E.tab = S.tab; E.list = (const unsigned*)(F.ws + WS_LIST); E.gate = (const float*)(F.ws + WS_GATE); E.ym = (bf16_t*)(F.ws + WS_YM);
    int nt = DEXP / 64; asm volatile("" : "+s"(nt));
    pg8::gemm_phase<EpiMoeOut, SchedMoe2, false>(F.lds, S, E, DEXP, DEXP, nt);
}

__device__ __forceinline__ void p7_final(const Args& A, Frame& F) {
    const int gw = F.bx * NWAVES + F.wave, NGW = F.G * NWAVES, lane = F.lane; const bf16_t* YM = (const bf16_t*)(F.ws + WS_YM);
    const f32x4* gp = (const f32x4*)((const float*)A.in[17]) + lane;
    for (int m0 = gw; m0 < T; m0 += 2 * NGW) {
        const int m1 = (m0 + NGW < T) ? m0 + NGW : m0;
        f32x4* hp0 = (f32x4*)(F.out + (size_t)m0 * D) + lane; f32x4* hp1 = (f32x4*)(F.out + (size_t)m1 * D) + lane;
        const u32x2* hb0 = (const u32x2*)((const bf16_t*)(F.ws + WS_H1) + (size_t)m0 * D) + lane; const u32x2* hb1 = (const u32x2*)((const bf16_t*)(F.ws + WS_H1) + (size_t)m1 * D) + lane;
        const u32x2* ya0 = (const u32x2*)(YM + (size_t)(2 * m0) * D) + lane; const u32x2* yb0 = (const u32x2*)(YM + (size_t)(2 * m0 + 1) * D) + lane;
        const u32x2* ya1 = (const u32x2*)(YM + (size_t)(2 * m1) * D) + lane; const u32x2* yb1 = (const u32x2*)(YM + (size_t)(2 * m1 + 1) * D) + lane;
        f32x4 v0[4], v1[4]; u32x2 a0[4], b0[4], a1[4], b1[4], c0[4], c1[4];
#pragma unroll
        for (int j = 0; j < 4; ++j) { c0[j] = hb0[64 * j]; a0[j] = ya0[64 * j]; b0[j] = yb0[64 * j]; c1[j] = hb1[64 * j]; a1[j] = ya1[64 * j]; b1[j] = yb1[64 * j]; }
#pragma unroll
        for (int j = 0; j < 4; ++j) { v0[j] = (f32x4){bf_lo(c0[j].x), bf_hi(c0[j].x), bf_lo(c0[j].y), bf_hi(c0[j].y)}; v1[j] = (f32x4){bf_lo(c1[j].x), bf_hi(c1[j].x), bf_lo(c1[j].y), bf_hi(c1[j].y)}; }
        float s0 = 0.f, s1 = 0.f;
#pragma unroll
        for (int j = 0; j < 4; ++j) {
            v0[j].x += bf_lo(a0[j].x) + bf_lo(b0[j].x); v0[j].y += bf_hi(a0[j].x) + bf_hi(b0[j].x); v0[j].z += bf_lo(a0[j].y) + bf_lo(b0[j].y); v0[j].w += bf_hi(a0[j].y) + bf_hi(b0[j].y);
            v1[j].x += bf_lo(a1[j].x) + bf_lo(b1[j].x); v1[j].y += bf_hi(a1[j].x) + bf_hi(b1[j].x); v1[j].z += bf_lo(a1[j].y) + bf_lo(b1[j].y); v1[j].w += bf_hi(a1[j].y) + bf_hi(b1[j].y);
            s0 += (v0[j].x * v0[j].x + v0[j].y * v0[j].y) + (v0[j].z * v0[j].z + v0[j].w * v0[j].w); s1 += (v1[j].x * v1[j].x + v1[j].y * v1[j].y) + (v1[j].z * v1[j].z + v1[j].w * v1[j].w); }
        const float r0 = 1.0f / sqrtf(wave_sum(s0) * (1.f / D) + EPS), r1 = 1.0f / sqrtf(wave_sum(s1) * (1.f / D) + EPS);
#pragma unroll
        for (int j = 0; j < 4; ++j) { const f32x4 g = gp[64 * j]; hp0[64 * j] = v0[j] * r0 * g; if (m1 != m0) hp1[64 * j] = v1[j] * r1 * g; }
    }
}

constexpr int N_PHASES = 11;
__global__ void __launch_bounds__(NWAVES * 64, 2) mega_fwd(Args A) {
    extern __shared__ __attribute__((aligned(16))) unsigned char lds_raw[];
    Frame F;
    F.lds = (LAS unsigned char*)lds_raw; F.tid = threadIdx.x; F.lane = F.tid & 63; F.wave = __builtin_amdgcn_readfirstlane(F.tid >> 6); F.G = gridDim.x; F.bx = blockIdx.x;
    F.out = A.out; F.ws = A.ws;
    volatile LAS unsigned* MISC = (volatile LAS unsigned*)(F.lds + MISC_OFF);
    if (F.tid < 64) MISC[F.tid] = 0u;
    __builtin_amdgcn_fence(__ATOMIC_ACQUIRE, "agent");
    asm volatile("s_waitcnt vmcnt(0) lgkmcnt(0)" ::: "memory");
    __syncthreads();
    const int lo = A.ph_lo, hi = A.ph_hi;
    XcdBarrier bar; bar.bar = (unsigned*)(F.ws + WS_CTL) + CW_BAR; bar.x = 0; bar.st = MISC + 8;
    if (hi - lo > 1) bar = xcd_barrier_post((unsigned*)(F.ws + WS_CTL) + CW_BAR, MISC + 8);
#ifndef PH_MASK
#define PH_MASK 0x7ff
#endif
#define IN(k) (((PH_MASK >> (k)) & 1) && lo <= (k) && (k) < hi)
#define SEAM(k) do { if (IN(k) && IN((k) + 1)) xcd_barrier(bar); } while (0)
#ifndef DUP_MASK
#define DUP_MASK 0
#endif
#define DUP(k) ((DUP_MASK >> (k)) & 1)
    if (IN(0)) { if (DUP(0)) { p0_prep(A, F); xcd_barrier(bar); } p0_prep(A, F); SEAM(0); }
    if (IN(1)) { if (DUP(1)) { p1_proj(A, F); xcd_barrier(bar); } p1_proj(A, F); SEAM(1); }
    if (IN(2)) {
#ifndef NO_P2A
        if (DUP(2)) { p2a_index(A, F); xcd_barrier(bar); }
        p2a_index(A, F);
#endif
#ifndef NO_P2B
        p2b_sgu(A, F);
#endif
        SEAM(2); }
    if (IN(3)) {
#ifdef DUP_P3
        p3_attn(A, F, WS_XN1); xcd_barrier(bar);
#endif
        p3_attn(A, F); SEAM(3); }
    if (IN(4)) { if (DUP(4)) { p4a_merge(A, F); xcd_barrier(bar); } p4a_merge(A, F); SEAM(4); }
    if (IN(5)) { if (DUP(5)) { p4b_out(A, F); xcd_barrier(bar); } p4b_out(A, F); SEAM(5); }
    if (IN(6)) { if (DUP(6)) { p5_route(A, F); xcd_barrier(bar); } p5_route(A, F); SEAM(6); }
    if (IN(8)) { if (DUP(8)) { p6a_moe_in(A, F); xcd_barrier(bar); } p6a_moe_in(A, F); SEAM(8); }
    if (IN(9)) { if (DUP(9)) { p6b_moe_out(A, F); xcd_barrier(bar); } p6b_moe_out(A, F); SEAM(9); }
    if (IN(10)) { p7_final(A, F); }
    asm volatile("s_waitcnt vmcnt(0)" ::: "memory"); __syncthreads();
    if (F.tid == 0) { __builtin_amdgcn_fence(__ATOMIC_RELEASE, "agent"); asm volatile("s_waitcnt vmcnt(0)" ::: "memory"); }
#undef IN
#undef SEAM
}

#ifndef MK_N_LAUNCHES
#define MK_N_LAUNCHES 1
#endif
extern "C" void kernel_launch(void* const* d_in, const int* in_sizes, int n_in, void* d_out, int out_size, void* d_ws, size_t ws_size, hipStream_t stream) {
    static int grid = 0;
    if (grid == 0) {
        if (n_in != 18 || in_sizes[0] != T * D || out_size != T * D || ws_size < WS_TOTAL) {
            fprintf(stderr, "kernel_launch: unexpected problem (n_in %d, in0 %d, out %d, ws %zu; need ws >= %zu)\n", n_in, n_in > 0 ? in_sizes[0] : -1, out_size, ws_size, (size_t)WS_TOTAL); grid = -1; return; }
        int dev = 0, cus = 0, per_cu = 0;
        if (hipGetDevice(&dev) != hipSuccess || hipDeviceGetAttribute(&cus, hipDeviceAttributeMultiprocessorCount, dev) != hipSuccess) { grid = -1; return; }
        if (hipFuncSetAttribute((const void*)mega_fwd, hipFuncAttributeMaxDynamicSharedMemorySize, LDS_BYTES) != hipSuccess) { fprintf(stderr, "kernel_launch: hipFuncSetAttribute failed\n"); grid = -1; return; }
        if (hipOccupancyMaxActiveBlocksPerMultiprocessor(&per_cu, (const void*)mega_fwd, NWAVES * 64, LDS_BYTES) != hipSuccess || per_cu < 1) { fprintf(stderr, "kernel_launch: occupancy query says %d blocks per CU\n", per_cu); per_cu = 1; }
        (void)hipGetLastError();
        grid = cus;
    }
    if (grid < 0) return;
    (void)hipMemsetAsync((char*)d_ws + WS_CTL, 0, CTL_ZERO_BYTES, stream);
    Args a{};
    for (int i = 0; i < 18; ++i) a.in[i] = d_in[i];
    a.out = (float*)d_out; a.ws = (unsigned char*)d_ws;
    if (MK_N_LAUNCHES == 1) { a.ph_lo = 0; a.ph_hi = N_PHASES; hipLaunchKernelGGL(mega_fwd, dim3(grid), dim3(NWAVES * 64), LDS_BYTES, stream, a); }
    else for (int p = 0; p < N_PHASES; ++p) { a.ph_lo = p; a.ph_hi = p + 1; hipLaunchKernelGGL(mega_fwd, dim3(grid), dim3(NWAVES * 64), LDS_BYTES, stream, a); }
}
```

```cpp
#include <hip/hip_runtime.h>
#include <cstdio>
#include <cstdint>

#define LAS __attribute__((address_space(3)))
#define GAS __attribute__((address_space(1)))
typedef unsigned short bf16_t;
typedef short bf16x8 __attribute__((ext_vector_type(8)));
typedef short s16x4 __attribute__((ext_vector_type(4)));
typedef float f32x2 __attribute__((ext_vector_type(2)));
typedef float f32x4 __attribute__((ext_vector_type(4)));
typedef float f32x16 __attribute__((ext_vector_type(16)));
typedef unsigned u32x2 __attribute__((ext_vector_type(2)));
typedef unsigned u32x4 __attribute__((ext_vector_type(4)));
typedef unsigned long long u64;

constexpr int NB = 8, SEQ = 4096, D = 1024, T = NB * SEQ;
constexpr int NH = 8, HD = 128, IH = 8, ID = 64, TOPK = 256;
constexpr int NPROJ_SRC = 7752, NPROJ = 7936;
constexpr int NEXP = 32, DEXP = 256, EPG = 8, NGRP = 4;
constexpr float EPS = 1e-6f;
constexpr int SRC_Q = 0, SRC_K = 1024, SRC_V = 2048, SRC_QI = 3072, SRC_KI = 3584, SRC_WI = 3648, SRC_SU = 3656, SRC_SV = 4680, SRC_GA = 5704, SRC_GB = 6728;

constexpr size_t MiB = 1u << 20;
constexpr size_t WS_CTL = 0, CTL_ZERO_BYTES = 1 * MiB;
constexpr size_t WS_WIN = 1 * MiB;
constexpr size_t WS_WA = 17 * MiB, WS_WB = 19 * MiB, WS_WO = 21 * MiB;
constexpr size_t WS_ROPE = 23 * MiB;
constexpr size_t WS_WI = 39 * MiB;
constexpr size_t WS_KI = 40 * MiB;
constexpr size_t WS_SVST = 44 * MiB;
constexpr size_t WS_MASK = 52 * MiB;
constexpr size_t WS_QI = 68 * MiB;
constexpr size_t WS_XN1 = 100 * MiB;
constexpr size_t WS_Q = 164 * MiB;
constexpr size_t WS_K = 228 * MiB;
constexpr size_t WS_V = 292 * MiB;
constexpr size_t WS_SU = 356 * MiB;
constexpr size_t WS_SV = 420 * MiB;
constexpr size_t WS_END = 484 * MiB, WS_TOTAL = 485 * MiB;
constexpr size_t WS_WRT = WS_END;
constexpr size_t WS_RSTD = WS_WI + 512 * 1024;
constexpr size_t WS_H1 = WS_SU;
constexpr size_t WS_GATEL = WS_SVST, WS_RSTDL = WS_SVST + 4 * MiB;
constexpr size_t WS_GATE = WS_WI, WS_LIST = WS_KI, WS_MG = WS_XN1, WS_YM = WS_XN1, WS_XN2 = WS_K, WS_WEIN = WS_V, WS_WEOUT = WS_V + 32 * MiB, WS_ACT = WS_SV;
constexpr int CW_ECNT = 64;
constexpr int CW_BAR = 4096;

constexpr int LDS_BYTES = 160 * 1024;
constexpr int MISC_OFF = LDS_BYTES - 256;

__device__ __forceinline__ unsigned f2bf(float f) { unsigned u = __builtin_bit_cast(unsigned, f); return (u + 0x7fffu + ((u >> 16) & 1u)) >> 16; }
__device__ __forceinline__ unsigned pk2(float lo, float hi) { return f2bf(lo) | (f2bf(hi) << 16); }
__device__ __forceinline__ unsigned cvt_pk_bf16(float lo, float hi) { unsigned r; asm volatile("v_cvt_pk_bf16_f32 %0, %1, %2" : "=v"(r) : "v"(lo), "v"(hi)); return r; }
__device__ __forceinline__ float bf_lo(unsigned w) { return __builtin_bit_cast(float, w << 16); }
__device__ __forceinline__ float bf_hi(unsigned w) { return __builtin_bit_cast(float, w & 0xffff0000u); }
__device__ __forceinline__ float wave_sum(float v) {
#pragma unroll
    for (int o = 1; o < 64; o <<= 1) v += __shfl_xor(v, o);
    return v;
}
__device__ __forceinline__ float fast_sigmoid(float x) { return __builtin_amdgcn_rcpf(1.0f + __builtin_amdgcn_exp2f(-1.4426950408889634f * x)); }
__device__ __forceinline__ float gelu_tanh(float x) {
    const float u2 = 1.5957691216057308f * (x + 0.044715f * x * x * x);
    return x * fast_sigmoid(u2);
}

#define DPP_STEP(v, ctrl, rmask) ((v) + __builtin_bit_cast(float, __builtin_amdgcn_update_dpp(0, __builtin_bit_cast(int, (v)), (ctrl), (rmask), 0xF, false)))
__device__ __forceinline__ float wave_sum_dpp(float v) {
    v = DPP_STEP(v, 0xB1, 0xF);
    v = DPP_STEP(v, 0x4E, 0xF);
    v = DPP_STEP(v, 0x141, 0xF);
    v = DPP_STEP(v, 0x140, 0xF);
    v = DPP_STEP(v, 0x142, 0xA);
    v = DPP_STEP(v, 0x143, 0xC);
    return __builtin_bit_cast(float, __builtin_amdgcn_readlane(__builtin_bit_cast(int, v), 63));
}
#define LDS_WAIT() asm volatile("s_waitcnt lgkmcnt(0)" ::: "memory")
#define VM_WAIT() asm volatile("s_waitcnt vmcnt(0)" ::: "memory")

#define XB_TMO      128
#define XB_XCNT(j)  (256  + 64 * (j))
#define XB_XSUB(j)  (1280 + 64 * (j))
#define XB_XGEN(j)  (2304 + 64 * (j))
#define XB_TOP      3328
#define XB_TOPGEN   3392
#define XCD_BAR_WORDS 3456
#define XB_SPIN_CAP (1u << 22)
__device__ __forceinline__ unsigned xb_ld(unsigned* p)              { return __hip_atomic_load(p, __ATOMIC_RELAXED, __HIP_MEMORY_SCOPE_AGENT); }
__device__ __forceinline__ unsigned xb_add(unsigned* p, unsigned v) { return __hip_atomic_fetch_add(p, v, __ATOMIC_RELAXED, __HIP_MEMORY_SCOPE_AGENT); }
__device__ __forceinline__ unsigned xb_xcc_id() { return (unsigned)__builtin_amdgcn_s_getreg((3 << 11) | 20) & 0xFu; }
#define XB_SPIN(cond, bar) do { unsigned _sp = 0; while (cond) { __builtin_amdgcn_s_sleep(1); \
    if ((++_sp & 255u) == 0u) { if (xb_ld(&(bar)[XB_TMO])) break; if (_sp > XB_SPIN_CAP) { atomicAdd(&(bar)[XB_TMO], 1u); break; } } } } while (0)
struct XcdBarrier { unsigned* bar; unsigned x; volatile LAS unsigned* st; };
__device__ __forceinline__ XcdBarrier xcd_barrier_post(unsigned* bar, volatile LAS unsigned* st) {
    XcdBarrier b; b.bar = bar; b.x = xb_xcc_id(); b.st = st;
    if (threadIdx.x == 0) (void)xb_add(&bar[XB_XCNT(b.x)], 1u);
    return b;
}
__device__ __forceinline__ void xcd_barrier_complete(unsigned* bar, unsigned x, unsigned& nloc, unsigned& nx) {
    const unsigned G = gridDim.x * gridDim.y * gridDim.z;
    unsigned sum, cnt, mine, sp = 0u;
    for (;;) {
        sum = 0u; cnt = 0u; mine = 0u;
#pragma unroll
        for (unsigned j = 0; j < 16; ++j) { const unsigned c = xb_ld(&bar[XB_XCNT(j)]); sum += c; cnt += (c > 0u) ? 1u : 0u; mine = (j == x) ? c : mine; }
        if (sum == G) break;
        __builtin_amdgcn_s_sleep(1);
        if ((++sp & 255u) == 0u) { if (xb_ld(&bar[XB_TMO])) break; if (sp > XB_SPIN_CAP) { atomicAdd(&bar[XB_TMO], 1u); break; } }
    }
    nloc = mine > 0u ? mine : 1u; nx = cnt > 0u ? cnt : 1u;
}
__device__ __forceinline__ void xcd_barrier(const XcdBarrier& b) {
    asm volatile("s_waitcnt vmcnt(0)" ::: "memory");
    __syncthreads();
    if (threadIdx.x == 0) {
        unsigned* bar = b.bar;
        __builtin_amdgcn_s_waitcnt(0);
        unsigned nloc = b.st[0], nx = b.st[1];
        if (nloc == 0u) { xcd_barrier_complete(bar, b.x, nloc, nx); b.st[0] = nloc; b.st[1] = nx; }
        const unsigned old = xb_add(&bar[XB_XSUB(b.x)], 1u);
        const unsigned gen = old / nloc;
        if (old + 1u == (gen + 1u) * nloc) {
            __builtin_amdgcn_fence(__ATOMIC_RELEASE, "agent");
            asm volatile("s_waitcnt vmcnt(0)" ::: "memory");
            const unsigned og = xb_add(&bar[XB_TOP], 1u);
            const unsigned tg = og / nx;
            if (og + 1u == (tg + 1u) * nx) xb_add(&bar[XB_TOPGEN], 1u);
            else XB_SPIN(xb_ld(&bar[XB_TOPGEN]) == tg, bar);
            __builtin_amdgcn_fence(__ATOMIC_ACQUIRE, "agent");
            xb_add(&bar[XB_XGEN(b.x)], 1u);
            asm volatile("s_waitcnt vmcnt(0)" ::: "memory");
        } else {
            XB_SPIN(xb_ld(&bar[XB_XGEN(b.x)]) == gen, bar);
            __builtin_amdgcn_fence(__ATOMIC_ACQUIRE, "agent");
            asm volatile("s_waitcnt vmcnt(0)" ::: "memory");
        }
    }
    __syncthreads();
}

namespace pg8 {
constexpr int BM = 256, BK = 64, HALF = 128, HTB = HALF * BK * 2, STAGE_BYTES = 8 * HTB, NXCD = 8, WGM = 4;
__host__ __device__ __forceinline__ int lds_byte(int r, int c) { const int st = (r >> 4) * 2 + (c >> 5), rr = r & 15, cc = c & 31, ob = rr * 64 + cc * 2; return st * 1024 + (ob ^ (((ob >> 9) & 1) << 5)); }
__host__ __device__ __forceinline__ void stage_rc(int b, int& R, int& C) { const int st = b / 1024, sb = b % 1024, swz = sb ^ (((sb >> 9) & 1) << 5); R = (st >> 1) * 16 + swz / 64; C = (st & 1) * 32 + (swz % 64) / 2; }
__host__ __device__ __forceinline__ int perm32(int rho) { const int n = rho >> 4, i = rho & 15; return 8 * (i >> 2) + 4 * n + (i & 3); }

struct Seg { const char* A; const char* B; int pm, pn, kind, aux; };

__device__ __forceinline__ bool static_tile(int i, int G, int c, int nM, int nN, int& pm, int& pn) {
    const int nwg = nM * nN; const long L = (long)i * G + c; if (L >= nwg) return false;
    int wgid = (int)L; { const int q = nwg / NXCD, r = nwg % NXCD, xcd = wgid % NXCD, off = wgid / NXCD; wgid = (xcd < r ? xcd * (q + 1) : r * (q + 1) + (xcd - r) * q) + off; }
    const int nig = WGM * nN, gid = wgid / nig, fm = gid * WGM, gsz = (nM - fm) < WGM ? (nM - fm) : WGM;
    pm = fm + ((wgid % nig) % gsz); pn = (wgid % nig) / gsz; return true;
}

template <class Epi, class Sched, bool GATHER>
__device__ __forceinline__ void gemm_phase(LAS unsigned char* lds, const Sched& S, const Epi& E, const int lda, const int ldb, const int nt) {
    const int tid = threadIdx.x, wid = __builtin_amdgcn_readfirstlane(tid >> 6), lane = tid & 63, wr = wid >> 2, wc = wid & 3, fr = lane & 15, fq = lane >> 4;
    unsigned voffA[2][2], nvoffA[2][2], voffB[2]; int RR[2], CC[2];
    const size_t hstepA = (size_t)HALF * lda * 2, hstepB = (size_t)HALF * ldb * 2, kstep = (size_t)(BK * 2);
#pragma unroll
    for (int i = 0; i < 2; ++i) { int R, C; stage_rc(tid * 16 + i * 8192, R, C); RR[i] = R; CC[i] = C; const int Rb = Epi::PERM ? ((R & ~31) + perm32(R & 31)) : R;
        voffA[0][i] = (unsigned)(R * lda + C) * 2u; voffA[1][i] = voffA[0][i] + (unsigned)hstepA; voffB[i] = (unsigned)(Rb * ldb + C) * 2u;
        nvoffA[0][i] = voffA[0][i]; nvoffA[1][i] = voffA[1][i]; }
    const unsigned ldsw = (unsigned)wid * 1024u;
    const int aoff = lds_byte(wr * 64 + fr, fq * 8), boff = lds_byte(wc * 32 + fr, fq * 8);
#define PG8_SA(b, h) (((b) * 2 + (h)) * HTB)
#define PG8_SB(b, h) ((4 + (b) * 2 + (h)) * HTB)
#define PG8_STAGEA(bufoff, gbase, vo) do { _Pragma("unroll") for (int _i = 0; _i < 2; ++_i) \
        __builtin_amdgcn_global_load_lds((const unsigned*)((const char*)(gbase) + (vo)[_i]), (LAS unsigned*)(lds + (bufoff) + ldsw + _i * 8192), 16, 0, 0); } while (0)
#define PG8_STAGEB(bufoff, gbase) do { _Pragma("unroll") for (int _i = 0; _i < 2; ++_i) \
        __builtin_amdgcn_global_load_lds((const unsigned*)((const char*)(gbase) + voffB[_i]), (LAS unsigned*)(lds + (bufoff) + ldsw + _i * 8192), 16, 0, 0); } while (0)
#define PG8_LDA(dst, b, h) do { _Pragma("unroll") for (int m = 0; m < 4; ++m) _Pragma("unroll") for (int k = 0; k < 2; ++k) dst[m][k] = *(const LAS bf16x8*)(lds + PG8_SA(b, h) + aoff + m * 2048 + k * 1024); } while (0)
#define PG8_LDB(dst, b, h) do { _Pragma("unroll") for (int n = 0; n < 2; ++n) _Pragma("unroll") for (int k = 0; k < 2; ++k) dst[n][k] = *(const LAS bf16x8*)(lds + PG8_SB(b, h) + boff + n * 2048 + k * 1024); } while (0)
#define PG8_MMA(ai, bj, At, Bt) do { __builtin_amdgcn_s_setprio(1); _Pragma("unroll") for (int m = 0; m < 4; ++m) _Pragma("unroll") for (int n = 0; n < 2; ++n) _Pragma("unroll") for (int k = 0; k < 2; ++k) \
        acc[ai][bj][m][n] = __builtin_amdgcn_mfma_f32_16x16x32_bf16(Bt[n][k], At[m][k], acc[ai][bj][m][n], 0, 0, 0); __builtin_amdgcn_s_setprio(0); } while (0)
#define PG8_WAIT_V(n) asm volatile("s_waitcnt vmcnt(" #n ")" ::: "memory")
#define PG8_WAIT_VX(relax) do { if constexpr (Epi::NST == 16) asm volatile("s_waitcnt vmcnt(24)\n\ts_cmp_lg_u32 %0, 0\n\ts_cbranch_scc1 .Lpg8w%=\n\ts_waitcnt vmcnt(8)\n.Lpg8w%=:" :: "s"(relax) : "memory", "scc"); \
        else if constexpr (Epi::NST == 8) asm volatile("s_waitcnt vmcnt(16)\n\ts_cmp_lg_u32 %0, 0\n\ts_cbranch_scc1 .Lpg8w%=\n\ts_waitcnt vmcnt(8)\n.Lpg8w%=:" :: "s"(relax) : "memory", "scc"); \
        else PG8_WAIT_V(8); } while (0)
#define PG8_WAIT_L(n) asm volatile("s_waitcnt lgkmcnt(" #n ")" ::: "memory")
#define PG8_BAR __builtin_amdgcn_s_barrier()
#define PG8_SCHED __builtin_amdgcn_sched_barrier(0)
    Seg cur, nxt; int ui = 0;
    if (!S.next(0, cur)) return;
    f32x4 acc[2][2][4][2];
#pragma unroll
    for (int a = 0; a < 2; ++a)
#pragma unroll
        for (int b = 0; b < 2; ++b)
#pragma unroll
            for (int m = 0; m < 4; ++m)
#pragma unroll
                for (int n = 0; n < 2; ++n) acc[a][b][m][n] = (f32x4){0.f, 0.f, 0.f, 0.f};
    bf16x8 At[4][2], B0[2][2], B1[2][2];
    const char* cA = cur.A; const char* cB = cur.B;
    if constexpr (GATHER) {
#pragma unroll
        for (int h = 0; h < 2; ++h)
#pragma unroll
            for (int i = 0; i < 2; ++i) voffA[h][i] = (unsigned)(S.row(cur, RR[i] + HALF * h) * lda + CC[i]) * 2u;
    }
    PG8_STAGEB(PG8_SB(0, 0), cB); PG8_STAGEB(PG8_SB(0, 1), cB + hstepB); PG8_STAGEA(PG8_SA(0, 0), cA, voffA[0]); PG8_STAGEA(PG8_SA(0, 1), cA, voffA[1]);
    if (wr == 1) PG8_BAR;
    PG8_WAIT_V(2); PG8_BAR;
    PG8_STAGEB(PG8_SB(1, 0), cB + kstep); PG8_STAGEA(PG8_SA(1, 0), cA + kstep, voffA[0]); PG8_STAGEB(PG8_SB(1, 1), cB + hstepB + kstep);
    PG8_WAIT_V(6); PG8_BAR;
    for (;;) {
        const bool has_next = S.next(ui + 1, nxt);
        const char* nA = has_next ? nxt.A : cA; const char* nB = has_next ? nxt.B : cB;
        if constexpr (GATHER) {
            if (has_next) {
#pragma unroll
                for (int h = 0; h < 2; ++h)
#pragma unroll
                    for (int i = 0; i < 2; ++i) nvoffA[h][i] = (unsigned)(S.row(nxt, RR[i] + HALF * h) * lda + CC[i]) * 2u;
            } else {
#pragma unroll
                for (int h = 0; h < 2; ++h)
#pragma unroll
                    for (int i = 0; i < 2; ++i) nvoffA[h][i] = voffA[h][i];
            }
        }
        for (int t = 0; t < nt; t += 2) {
            const bool last = (t == nt - 2); const int ax = __builtin_amdgcn_readfirstlane(((t == 0) && (ui > 0) && (cur.kind & 1)) ? 1 : 0);
            const char* a1 = cA + (size_t)(t + 1) * kstep;
            const char* a2 = last ? nA : cA + (size_t)(t + 2) * kstep; const char* b2 = last ? nB : cB + (size_t)(t + 2) * kstep;
            const char* a3 = a2 + kstep; const char* b3 = b2 + kstep;
            unsigned v20, v21, v30, v31, w20, w21;
            if constexpr (GATHER) { v20 = last ? nvoffA[0][0] : voffA[0][0]; v21 = last ? nvoffA[0][1] : voffA[0][1]; w20 = last ? nvoffA[1][0] : voffA[1][0]; w21 = last ? nvoffA[1][1] : voffA[1][1]; }
            else { v20 = voffA[0][0]; v21 = voffA[0][1]; w20 = voffA[1][0]; w21 = voffA[1][1]; }
            v30 = v20; v31 = v21;
            const unsigned vh0[2] = {v20, v21}, vh1[2] = {w20, w21};
            PG8_LDB(B0, 0, 0); PG8_LDB(B1, 0, 1); PG8_SCHED; PG8_LDA(At, 0, 0); PG8_STAGEA(PG8_SA(1, 1), a1, voffA[1]);
            PG8_WAIT_VX(ax); PG8_WAIT_L(0); PG8_BAR; PG8_MMA(0, 0, At, B0); PG8_MMA(0, 1, At, B1); PG8_BAR; PG8_SCHED;
            PG8_LDA(At, 0, 1); PG8_STAGEB(PG8_SB(0, 0), b2); PG8_STAGEB(PG8_SB(0, 1), b2 + hstepB); PG8_STAGEA(PG8_SA(0, 0), a2, vh0);
            PG8_WAIT_VX(ax); PG8_WAIT_L(0); PG8_BAR; PG8_MMA(1, 0, At, B0); PG8_MMA(1, 1, At, B1); PG8_BAR; PG8_SCHED;
            PG8_LDB(B0, 1, 0); PG8_LDB(B1, 1, 1); PG8_SCHED; PG8_LDA(At, 1, 0); PG8_STAGEA(PG8_SA(0, 1), a2, vh1);
            PG8_WAIT_V(8); PG8_WAIT_L(0); PG8_BAR; PG8_MMA(0, 0, At, B0); PG8_MMA(0, 1, At, B1); PG8_BAR; PG8_SCHED;
            PG8_LDA(At, 1, 1); PG8_STAGEB(PG8_SB(1, 0), b3); PG8_STAGEB(PG8_SB(1, 1), b3 + hstepB); PG8_STAGEA(PG8_SA(1, 0), a3, vh0);
            PG8_WAIT_V(8); PG8_WAIT_L(0); PG8_BAR; PG8_MMA(1, 0, At, B0); PG8_MMA(1, 1, At, B1); PG8_BAR; PG8_SCHED;
            (void)v30; (void)v31;
        }
        if (wr == 0) PG8_BAR;
        asm volatile("s_nop 15\n\ts_nop 15" ::: "memory");
        if (cur.kind & 2) E(acc, cur, wr, wc, fr, fq); else E.mid(acc, cur, wr, wc, fr, fq);
        if (!has_next) break;
        if (nxt.kind & 1) {
#pragma unroll
            for (int a = 0; a < 2; ++a)
#pragma unroll
                for (int b = 0; b < 2; ++b)
#pragma unroll
                    for (int m = 0; m < 4; ++m)
#pragma unroll
                        for (int n = 0; n < 2; ++n) acc[a][b][m][n] = (f32x4){0.f, 0.f, 0.f, 0.f};
        }
        cur = nxt; cA = nA; cB = nB; ++ui;
        if constexpr (GATHER) {
#pragma unroll
            for (int h = 0; h < 2; ++h)
#pragma unroll
                for (int i = 0; i < 2; ++i) voffA[h][i] = nvoffA[h][i];
        }
        if (wr == 1) PG8_BAR;
    }
    PG8_WAIT_V(0);
    PG8_BAR;
#undef PG8_SA
#undef PG8_SB
#undef PG8_STAGEA
#undef PG8_STAGEB
#undef PG8_LDA
#undef PG8_LDB
#undef PG8_MMA
#undef PG8_WAIT_V
#undef PG8_WAIT_VX
#undef PG8_WAIT_L
#undef PG8_BAR
#undef PG8_SCHED
}
}

constexpr int NWAVES = 8;
struct Args { const void* in[18]; float* out; unsigned char* ws; int ph_lo, ph_hi; };
struct Frame {
    LAS unsigned char* lds; int tid, lane, wave, G, bx; float* out; unsigned char* ws;
};

__device__ __forceinline__ int win_src(int n) {
    if (n < 2048) { const int seg = n >> 10, h = (n >> 7) & 7, p = n & 127; return seg * 1024 + h * 128 + (p >> 1) + 64 * (p & 1); }
    if (n < 3072) return SRC_V + (n - 2048);
    if (n < 4096) return SRC_SU + (n - 3072);
    if (n < 5120) return SRC_SV + (n - 4096);
    if (n < 6144) return SRC_GA + (n - 5120);
    if (n < 7168) return SRC_GB + (n - 6144);
    if (n < 7680) { const int m = n - 7168, h = m >> 6, p = m & 63; return SRC_QI + h * 64 + (p >> 1) + 32 * (p & 1); }
    if (n < 7744) { const int p = n - 7680; return SRC_KI + (p >> 1) + 32 * (p & 1); }
    if (n < 7752) return SRC_WI + (n - 7744);
    return -1;
}
__device__ __forceinline__ int wein_src(int r) { const int t = r >> 8, q = r & 255; return (q < 128) ? (128 * t + q) : (256 + 128 * t + (q - 128)); }

template <int MAP>
__device__ __forceinline__ void transpose_item(const float* W, int K, int N, int NDEST, bf16_t* WT, LAS float* scr, int item, int lane, const float* kscale = nullptr) {
    const int nblk = NDEST / 32, kb = item / nblk, nb = item % nblk, k0 = 64 * kb, n0 = 32 * nb;
    const int nd = n0 + (lane & 31); int src = nd; if (MAP == 1) src = win_src(nd); if (MAP == 2) src = wein_src(nd);
    float tv[32];
#pragma unroll
    for (int i = 0; i < 32; ++i) { const int kk = 2 * i + (lane >> 5); tv[i] = (src >= 0) ? W[(size_t)(k0 + kk) * N + src] : 0.f; }
#pragma unroll
    for (int i = 0; i < 32; ++i) { const int kk = 2 * i + (lane >> 5); scr[kk * 33 + (lane & 31)] = tv[i]; }
    LDS_WAIT(); asm volatile("" ::: "memory");
    const int c = lane & 7;
    f32x4 q0 = {1.f, 1.f, 1.f, 1.f}, q1 = q0; if (kscale) { q0 = *(const f32x4*)(kscale + k0 + 8 * c); q1 = *(const f32x4*)(kscale + k0 + 8 * c + 4); }
#pragma unroll
    for (int j = 0; j < 4; ++j) { const int n = (lane >> 3) + 8 * j; const LAS float* s = scr + (8 * c) * 33 + n;
        u32x4 o; o.x = pk2(s[0 * 33] * q0[0], s[1 * 33] * q0[1]); o.y = pk2(s[2 * 33] * q0[2], s[3 * 33] * q0[3]); o.z = pk2(s[4 * 33] * q1[0], s[5 * 33] * q1[1]); o.w = pk2(s[6 * 33] * q1[2], s[7 * 33] * q1[3]);
        *(u32x4*)(WT + (size_t)(n0 + n) * K + k0 + 8 * c) = o; }
    LDS_WAIT(); asm volatile("" ::: "memory");
}
__device__ __forceinline__ void split_pair(float a, float b, unsigned& hi, unsigned& lo) {
    const unsigned ua = __builtin_bit_cast(unsigned, a), ub = __builtin_bit_cast(unsigned, b);
    hi = (ub & 0xffff0000u) | (ua >> 16);
    lo = cvt_pk_bf16(a - __builtin_bit_cast(float, ua & 0xffff0000u), b - __builtin_bit_cast(float, ub & 0xffff0000u));
}
__device__ __forceinline__ void rms_row_to_bf16(const float* xrow, const float* g, bf16_t* orow, int lane) {
    const f32x4* xr = (const f32x4*)xrow + lane; const f32x4* gr = (const f32x4*)g + lane;
    f32x4 v[4]; float s = 0.f;
#pragma unroll
    for (int j = 0; j < 4; ++j) { v[j] = xr[64 * j]; s += (v[j].x * v[j].x + v[j].y * v[j].y) + (v[j].z * v[j].z + v[j].w * v[j].w); }
    const float rstd = 1.0f / sqrtf(wave_sum(s) * (1.f / D) + EPS);
    u64* o8 = (u64*)orow + lane;
#pragma unroll
    for (int j = 0; j < 4; ++j) { const f32x4 gg = gr[64 * j];
        o8[64 * j] = (u64)pk2(v[j].x * rstd * gg.x, v[j].y * rstd * gg.y) | ((u64)pk2(v[j].z * rstd * gg.z, v[j].w * rstd * gg.w) << 32); }
}
__device__ __forceinline__ void p0_prep(const Args& A, Frame& F) {
    LAS float* scr = (LAS float*)(F.lds + F.wave * 16384);
    const int gw = F.bx * NWAVES + F.wave, NGW = F.G * NWAVES;
    bf16_t* WinT = (bf16_t*)(F.ws + WS_WIN); bf16_t* WaT = (bf16_t*)(F.ws + WS_WA); bf16_t* WbT = (bf16_t*)(F.ws + WS_WB); bf16_t* WoT = (bf16_t*)(F.ws + WS_WO);
    constexpr int I_IN = (D / 64) * (NPROJ / 32), I_SQ = (D / 64) * (D / 32);
    for (int it = gw; it < I_IN + 3 * I_SQ; it += NGW) {
        int r = it;
        if (r < I_IN) { transpose_item<1>(((const float*)A.in[3]), D, NPROJ_SRC, NPROJ, WinT, scr, r, F.lane); continue; } r -= I_IN;
        if (r < I_SQ) { transpose_item<0>(((const float*)A.in[7]), D, D, D, WaT, scr, r, F.lane); continue; } r -= I_SQ;
        if (r < I_SQ) { transpose_item<0>(((const float*)A.in[8]), D, D, D, WbT, scr, r, F.lane); continue; } r -= I_SQ;
        transpose_item<0>(((const float*)A.in[9]), D, D, D, WoT, scr, r, F.lane);
    }
    { unsigned* WIMG = (unsigned*)(F.ws + WS_WRT); const float* g2 = (const float*)A.in[10];
      for (int i = F.bx * 512 + F.tid; i < 36 * 512; i += F.G * 512) { const int c = i >> 9, k = (i & 511) * 2;
          const float w0 = (c < 4) ? ((const float*)A.in[11])[k * 4 + c] : ((const float*)A.in[13])[k * 32 + (c - 4)], w1 = (c < 4) ? ((const float*)A.in[11])[(k + 1) * 4 + c] : ((const float*)A.in[13])[(k + 1) * 32 + (c - 4)];
          unsigned hi, lo; split_pair(w0 * g2[k], w1 * g2[k + 1], hi, lo); WIMG[i] = hi; WIMG[36 * 512 + i] = lo; } }
    bf16_t* XN1 = (bf16_t*)(F.ws + WS_XN1);
    f32x4 g1q[4];
#pragma unroll
    for (int j = 0; j < 4; ++j) g1q[j] = ((const f32x4*)((const float*)A.in[2]) + F.lane)[64 * j];
    for (int m0 = gw; m0 < T; m0 += 2 * NGW) {
        const int m1 = (m0 + NGW < T) ? m0 + NGW : m0;
        const f32x4* x0 = (const f32x4*)(((const float*)A.in[0]) + (size_t)m0 * D) + F.lane; const f32x4* x1 = (const f32x4*)(((const float*)A.in[0]) + (size_t)m1 * D) + F.lane;
        f32x4 v0[4], v1[4]; float s0 = 0.f, s1 = 0.f;
#pragma unroll
        for (int j = 0; j < 4; ++j) { v0[j] = x0[64 * j]; v1[j] = x1[64 * j]; }
#pragma unroll
        for (int j = 0; j < 4; ++j) { s0 += (v0[j].x * v0[j].x + v0[j].y * v0[j].y) + (v0[j].z * v0[j].z + v0[j].w * v0[j].w); s1 += (v1[j].x * v1[j].x + v1[j].y * v1[j].y) + (v1[j].z * v1[j].z + v1[j].w * v1[j].w); }
        const float r0 = 1.0f / sqrtf(wave_sum(s0) * (1.f / D) + EPS), r1 = 1.0f / sqrtf(wave_sum(s1) * (1.f / D) + EPS);
        u64* o0 = (u64*)(XN1 + (size_t)m0 * D) + F.lane; u64* o1 = (u64*)(XN1 + (size_t)m1 * D) + F.lane;
#pragma unroll
        for (int j = 0; j < 4; ++j) { const f32x4 gg = g1q[j];
            o0[64 * j] = (u64)pk2(v0[j].x * r0 * gg.x, v0[j].y * r0 * gg.y) | ((u64)pk2(v0[j].z * r0 * gg.z, v0[j].w * r0 * gg.w) << 32);
            if (m1 != m0) o1[64 * j] = (u64)pk2(v1[j].x * r1 * gg.x, v1[j].y * r1 * gg.y) | ((u64)pk2(v1[j].z * r1 * gg.z, v1[j].w * r1 * gg.w) << 32); }
    }
}


template <int OFF> __device__ __forceinline__ void ald16(f32x4& d, const void* p) { asm volatile("global_load_dwordx4 %0, %1, off offset:%2" : "=v"(d) : "v"(p), "i"(OFF) : "memory"); }
template <int OFF> __device__ __forceinline__ void ald16u(u32x4& d, const void* p) { asm volatile("global_load_dwordx4 %0, %1, off offset:%2" : "=v"(d) : "v"(p), "i"(OFF) : "memory"); }
__device__ __forceinline__ void ald4(unsigned& d, const void* p) { asm volatile("global_load_dword %0, %1, off" : "=v"(d) : "v"(p) : "memory"); }
__device__ __forceinline__ void ald4f(float& d, const void* p) { asm volatile("global_load_dword %0, %1, off" : "=v"(d) : "v"(p) : "memory"); }
#define AWAIT8(a, b, c, d, e, f, g, h) asm volatile("s_waitcnt vmcnt(0)" : "+v"(a), "+v"(b), "+v"(c), "+v"(d), "+v"(e), "+v"(f), "+v"(g), "+v"(h) :: "memory")
#define AWAIT4(a, b, c, d) asm volatile("s_waitcnt vmcnt(0)" : "+v"(a), "+v"(b), "+v"(c), "+v"(d) :: "memory")

struct SchedDense {
    const char* A; const char* B; int nM, nN, G, c; size_t tstepA, tstepB;
    __device__ __forceinline__ bool next(int i, pg8::Seg& s) const {
        int pm, pn; if (!pg8::static_tile(i, G, c, nM, nN, pm, pn)) return false;
        s.pm = pm; s.pn = pn; s.A = A + (size_t)pm * tstepA; s.B = B + (size_t)pn * tstepB; s.kind = 3; s.aux = 0; return true;
    }
    __device__ __forceinline__ int row(const pg8::Seg&, int) const { return 0; }
};

__device__ __forceinline__ u32x4 pack8v(f32x4 a, f32x4 b) { u32x4 w; w.x = cvt_pk_bf16(a[0], a[1]); w.y = cvt_pk_bf16(a[2], a[3]); w.z = cvt_pk_bf16(b[0], b[1]); w.w = cvt_pk_bf16(b[2], b[3]); return w; }
__device__ __forceinline__ void rope4(f32x4& v, f32x4 cs) {
    const float a0 = v[0] * cs[0] - v[1] * cs[1], a1 = v[1] * cs[0] + v[0] * cs[1], b0 = v[2] * cs[2] - v[3] * cs[3], b1 = v[3] * cs[2] + v[2] * cs[3];
    v = (f32x4){a0, a1, b0, b1};
}
__device__ __forceinline__ f32x2 cos_sin(float ang) {
    const float C1 = 0.15915494f, C2 = 6.4206383e-09f;
    const float k = __builtin_floorf(ang * C1); const float r = fmaf(ang, C2, fmaf(ang, C1, -k));
    return (f32x2){__builtin_amdgcn_cosf(r), __builtin_amdgcn_sinf(r)};
}
__device__ __forceinline__ float rope_freq(int entry) { return __builtin_amdgcn_exp2f(-(float)entry * (13.287712379549449f / 64.0f)); }
struct EpiProj {
    static constexpr bool PERM = true; static constexpr int NST = 8;
    unsigned char* ws; unsigned char* outb; const int* pos;
    __device__ __forceinline__ void mid(f32x4 (&)[2][2][4][2], const pg8::Seg&, int, int, int, int) const {}
    __device__ __forceinline__ void operator()(f32x4 (&acc)[2][2][4][2], const pg8::Seg& u, int wr, int wc, int fr, int fq) const {
        const int pn = u.pn, row0 = u.pm * 256 + wr * 64 + fr, cl = wc * 32 + 8 * fq;
        unsigned ps[2][4];
        if (pn < 8 || pn >= 28) {
#pragma unroll
            for (int ai = 0; ai < 2; ++ai)
#pragma unroll
                for (int m = 0; m < 4; ++m) ald4(ps[ai][m], pos + row0 + ai * 128 + m * 16);
            AWAIT8(ps[0][0], ps[0][1], ps[0][2], ps[0][3], ps[1][0], ps[1][1], ps[1][2], ps[1][3]); }
        if (pn < 8) {
            bf16_t* dst = (bf16_t*)(ws + (pn < 4 ? WS_Q : WS_K)) + (pn & 3) * 256 + cl;
            float fr4[4];
#pragma unroll
            for (int j = 0; j < 4; ++j) fr4[j] = rope_freq(16 * wc + 4 * fq + j);
#pragma unroll
            for (int ai = 0; ai < 2; ++ai)
#pragma unroll
                for (int m = 0; m < 4; ++m) { const int row = row0 + ai * 128 + m * 16; const float pf = (float)(int)ps[ai][m];
                    const f32x2 a0 = cos_sin(pf * fr4[0]), a1 = cos_sin(pf * fr4[1]), a2 = cos_sin(pf * fr4[2]), a3 = cos_sin(pf * fr4[3]);
                    const f32x4 c0 = {a0.x, a0.y, a1.x, a1.y}, c1 = {a2.x, a2.y, a3.x, a3.y};
#pragma unroll
                    for (int bj = 0; bj < 2; ++bj) { f32x4 v0 = acc[ai][bj][m][0], v1 = acc[ai][bj][m][1]; rope4(v0, c0); rope4(v1, c1);
                        *(u32x4*)(dst + (size_t)row * 1024 + bj * 128) = pack8v(v0, v1); } }
        } else if (pn < 28) {
            const int kind = (pn - 8) >> 2;
            bf16_t* dst;
            if (kind == 0) dst = (bf16_t*)(ws + WS_V); else if (kind == 1) dst = (bf16_t*)(ws + WS_SU); else if (kind == 2) dst = (bf16_t*)(ws + WS_SV);
            else if (kind == 3) dst = (bf16_t*)outb; else dst = (bf16_t*)(outb + 64 * MiB);
            dst += (pn & 3) * 256 + cl;
            f32x2* SVST = (f32x2*)(ws + WS_SVST);
#pragma unroll
            for (int ai = 0; ai < 2; ++ai)
#pragma unroll
                for (int m = 0; m < 4; ++m) { const int row = row0 + ai * 128 + m * 16;
#pragma unroll
                    for (int bj = 0; bj < 2; ++bj) { f32x4 v0 = acc[ai][bj][m][0], v1 = acc[ai][bj][m][1];
                        if (kind == 1 || kind == 2) {
#pragma unroll
                            for (int j = 0; j < 4; ++j) { v0[j] = gelu_tanh(v0[j]); v1[j] = gelu_tanh(v1[j]); } }
                        if (kind >= 3) {
#pragma unroll
                            for (int j = 0; j < 4; ++j) { v0[j] = fast_sigmoid(v0[j]); v1[j] = fast_sigmoid(v1[j]); } }
                        if (kind == 2) { float s = (v0[0] + v0[1]) + (v0[2] + v0[3]) + (v1[0] + v1[1]) + (v1[2] + v1[3]);
                            float q = (v0[0] * v0[0] + v0[1] * v0[1]) + (v0[2] * v0[2] + v0[3] * v0[3]) + (v1[0] * v1[0] + v1[1] * v1[1]) + (v1[2] * v1[2] + v1[3] * v1[3]);
                            s += __shfl_xor(s, 16); s += __shfl_xor(s, 32); q += __shfl_xor(q, 16); q += __shfl_xor(q, 32);
                            if (fq == 0) SVST[(size_t)row * 32 + (pn & 3) * 8 + bj * 4 + wc] = (f32x2){s, q}; }
                        *(u32x4*)(dst + (size_t)row * 1024 + bj * 128) = pack8v(v0, v1); } }
        } else {
            float fr4[4];
#pragma unroll
            for (int j = 0; j < 4; ++j) fr4[j] = rope_freq(32 * (wc & 1) + 8 * fq + 2 * j);
#pragma unroll
            for (int ai = 0; ai < 2; ++ai)
#pragma unroll
                for (int m = 0; m < 4; ++m) { const int row = row0 + ai * 128 + m * 16; const float pf = (float)(int)ps[ai][m];
                    const f32x2 a0 = cos_sin(pf * fr4[0]), a1 = cos_sin(pf * fr4[1]), a2 = cos_sin(pf * fr4[2]), a3 = cos_sin(pf * fr4[3]);
                    const f32x4 c0 = {a0.x, a0.y, a1.x, a1.y}, c1 = {a2.x, a2.y, a3.x, a3.y};
#pragma unroll
                    for (int bj = 0; bj < 2; ++bj) { f32x4 v0 = acc[ai][bj][m][0], v1 = acc[ai][bj][m][1];
                        if (pn < 30) { rope4(v0, c0); rope4(v1, c1); *(u32x4*)((bf16_t*)(ws + WS_QI) + (size_t)row * 512 + (pn - 28) * 256 + bj * 128 + cl) = pack8v(v0, v1); }
                        else if (bj == 0) {
                            if (wc < 2) { rope4(v0, c0); rope4(v1, c1); const int c8 = cl >> 3; *(u32x4*)((bf16_t*)(ws + WS_KI) + ((((size_t)row >> 5) * 4 + (c8 >> 1)) * 64 + (row & 31) + 32 * (c8 & 1)) * 8) = pack8v(v0, v1); }
                            else if (wc == 2 && fq == 0) { float* wi = (float*)(ws + WS_WI) + (size_t)row * 8; *(f32x4*)wi = v0; *(f32x4*)(wi + 4) = v1; } } } }
        }
    }
};
__device__ __forceinline__ void p1_proj(const Args& A, Frame& F) {
    SchedDense S; S.A = (const char*)(F.ws + WS_XN1); S.B = (const char*)(F.ws + WS_WIN); S.nM = T / 256; S.nN = NPROJ / 256; S.G = F.G; S.c = F.bx; S.tstepA = (size_t)256 * D * 2; S.tstepB = (size_t)256 * D * 2;
    EpiProj E; E.ws = F.ws; E.outb = (unsigned char*)F.out; E.pos = (const int*)A.in[1];
    pg8::gemm_phase<EpiProj, SchedDense, false>(F.lds, S, E, D, D, D / 64);
}

constexpr int P2_SC = 0, P2_ROWB = 131072, P2_HIST = 147456;
__device__ __forceinline__ float fma1(float a, float b, float c) { float d; asm("v_fma_f32 %0, %1, %2, %3" : "=v"(d) : "v"(a), "v"(b), "v"(c)); return d; }
__device__ __forceinline__ float relu_bits(float x) { const int i = __builtin_bit_cast(int, x); return __builtin_bit_cast(float, i > 0 ? i : 0); }
__device__ __forceinline__ unsigned mono_key(float f) { const unsigned u = __builtin_bit_cast(unsigned, f); return u ^ ((u >> 31) ? 0xffffffffu : 0x80000000u); }

__device__ __forceinline__ int wave_isum_dpp(int v) {
#define IDPP(v, ctrl, rmask) ((v) + __builtin_amdgcn_update_dpp(0, (v), (ctrl), (rmask), 0xF, false))
    v = IDPP(v, 0xB1, 0xF); v = IDPP(v, 0x4E, 0xF); v = IDPP(v, 0x141, 0xF); v = IDPP(v, 0x140, 0xF); v = IDPP(v, 0x142, 0xA); v = IDPP(v, 0x143, 0xC);
#undef IDPP
    return __builtin_amdgcn_readlane(v, 63);
}
__device__ __forceinline__ void wave_isum2_dpp(int& a, int& b) {
#define IDPP(v, ctrl, rmask) ((v) + __builtin_amdgcn_update_dpp(0, (v), (ctrl), (rmask), 0xF, false))
    a = IDPP(a, 0xB1, 0xF); b = IDPP(b, 0xB1, 0xF); a = IDPP(a, 0x4E, 0xF); b = IDPP(b, 0x4E, 0xF); a = IDPP(a, 0x141, 0xF); b = IDPP(b, 0x141, 0xF);
    a = IDPP(a, 0x140, 0xF); b = IDPP(b, 0x140, 0xF); a = IDPP(a, 0x142, 0xA); b = IDPP(b, 0x142, 0xA); a = IDPP(a, 0x143, 0xC); b = IDPP(b, 0x143, 0xC);
#undef IDPP
    a = __builtin_amdgcn_readlane(a, 63); b = __builtin_amdgcn_readlane(b, 63);
}
__device__ __forceinline__ void bit_transpose32(unsigned (&w)[32]) {
#pragma unroll
    for (int k = 0; k < 32; ++k) if (!(k & 16)) { const unsigned a = w[k], b = w[k + 16]; w[k] = __builtin_amdgcn_perm(b, a, 0x05040100u); w[k + 16] = __builtin_amdgcn_perm(b, a, 0x07060302u); }
#pragma unroll
    for (int k = 0; k < 32; ++k) if (!(k & 8)) { const unsigned a = w[k], b = w[k + 8]; w[k] = __builtin_amdgcn_perm(b, a, 0x06020400u); w[k + 8] = __builtin_amdgcn_perm(b, a, 0x07030501u); }
#pragma unroll
    for (int st = 0; st < 3; ++st) { const int j = 4 >> st; const unsigned m = (st == 0) ? 0x0F0F0F0Fu : (st == 1) ? 0x33333333u : 0x55555555u;
#pragma unroll
        for (int k = 0; k < 32; ++k) if (!(k & j)) { const unsigned a = w[k], b = w[k + j]; w[k] = (a & m) | ((b << j) & ~m); w[k + j] = ((a >> j) & m) | (b & ~m); } }
}
template <bool HI>
__device__ __forceinline__ void p2a_select_row(LAS unsigned char* lds, int wave, int lane, int q, int rowslot) {
    const LAS unsigned* sc = (const LAS unsigned*)(lds + P2_SC) + wave * 4096;
    unsigned lo[32], hi[32];
#pragma unroll
    for (int i = 0; i < 32; ++i) { lo[i] = sc[i * 64 + lane]; hi[i] = HI ? sc[(32 + i) * 64 + lane] : 0u; }
    __syncthreads();
    const int nv = ((q - lane) >> 6) + 1;
    unsigned Alo = nv >= 32 ? 0xffffffffu : ((1u << nv) - 1u), Ahi = (HI && nv > 32) ? (nv >= 64 ? 0xffffffffu : ((1u << (nv - 32)) - 1u)) : 0u;
    bit_transpose32(lo); if (HI) bit_transpose32(hi);
    unsigned Glo = 0u, Ghi = 0u; int above = 0, alive = q + 1;
    bool live = true;
#define P2_STEP(b) if (live) { if (above + alive == TOPK) live = false; else {     \
        const unsigned p1l = lo[b], p1h = hi[b], p0l = lo[b - 1], p0h = hi[b - 1]; \
        const unsigned a1l = Alo & p1l, a1h = Ahi & p1h, S3l = a1l & p0l, S3h = a1h & p0h, S2l = a1l ^ S3l, S2h = a1h ^ S3h; \
        const unsigned a0l = Alo ^ a1l, a0h = Ahi ^ a1h, S1l = a0l & p0l, S1h = a0h & p0h; \
        int x = (__builtin_popcount(S3l) + __builtin_popcount(S3h)) | ((__builtin_popcount(S2l) + __builtin_popcount(S2h)) << 16), y = __builtin_popcount(S1l) + __builtin_popcount(S1h); \
        wave_isum2_dpp(x, y); \
        const int C3 = x & 0xffff, C2 = x >> 16, C1 = y; \
        if (above + C3 >= TOPK) { Alo = S3l; Ahi = S3h; alive = C3; } \
        else if (above + C3 + C2 >= TOPK) { above += C3; Glo |= S3l; Ghi |= S3h; Alo = S2l; Ahi = S2h; alive = C2; } \
        else if (above + C3 + C2 + C1 >= TOPK) { above += C3 + C2; Glo |= a1l; Ghi |= a1h; Alo = S1l; Ahi = S1h; alive = C1; } \
        else { above += C3 + C2 + C1; Glo |= a1l | S1l; Ghi |= a1h | S1h; Alo = a0l ^ S1l; Ahi = a0h ^ S1h; alive -= C3 + C2 + C1; } } }
    P2_STEP(31) P2_STEP(29) P2_STEP(27) P2_STEP(25) P2_STEP(23) P2_STEP(21) P2_STEP(19) P2_STEP(17) P2_STEP(15) P2_STEP(13) P2_STEP(11) P2_STEP(9) P2_STEP(7) P2_STEP(5) P2_STEP(3) P2_STEP(1)
#undef P2_STEP
    const int need = TOPK - above, eqtot = alive;
    unsigned Tlo = Alo, Thi = Ahi;
    if (eqtot != need) {
        int rem = need; Tlo = 0u; Thi = 0u;
#pragma unroll
        for (int j = 0; j < (HI ? 64 : 32); ++j) { const bool eq = (((j < 32 ? Alo : Ahi) >> (j & 31)) & 1u) != 0u; const u64 e = __ballot(eq);
            const int rank = (int)__builtin_amdgcn_mbcnt_hi((unsigned)(e >> 32), __builtin_amdgcn_mbcnt_lo((unsigned)e, 0u));
            if (eq && rank < rem) { if (j < 32) Tlo |= 1u << (j & 31); else Thi |= 1u << (j & 31); }
            rem -= __builtin_popcountll(e); }
    }
    *((LAS u32x2*)(lds + P2_ROWB) + rowslot * 64 + lane) = (u32x2){Glo | Tlo, Ghi | Thi};
}

__device__ __forceinline__ void p2a_group(const Args& A, Frame& F, int b, int g) {
    LAS unsigned char* lds = F.lds; const int lane = F.lane, wave = F.wave, tid = F.tid;
    const int t0 = 32 * g; const size_t tb = (size_t)b * SEQ;
    const bf16_t* QI = (const bf16_t*)(F.ws + WS_QI); const bf16_t* KI = (const bf16_t*)(F.ws + WS_KI); const float* WI = (const float*)(F.ws + WS_WI);
    if (g < 8) {
        for (int idx = tid; idx < 32 * 64; idx += 512) { const int ql = idx >> 6, ln = idx & 63, t = t0 + ql; const int n = (t >= ln) ? ((t - ln) >> 6) + 1 : 0;
            const u64 w = (n >= 64) ? ~0ull : ((1ull << n) - 1ull);
            *((LAS u64*)(lds + P2_ROWB) + ql * 64 + ln) = w; }
    } else {
        const int r = lane & 31, hh = lane >> 5;
        bf16x8 af[2][4]; f32x4 wv[4][2]; bf16x8 bfr[4], nbf[4];
#define P2_ROUND_LOADS(q0_) do { \
            _Pragma("unroll") for (int mt = 0; mt < 2; ++mt) _Pragma("unroll") for (int ks = 0; ks < 4; ++ks) af[mt][ks] = *(const bf16x8*)(QI + (tb + (q0_) + (r & 7)) * 512 + (4 * mt + (r >> 3)) * 64 + 16 * ks + 8 * hh); \
            _Pragma("unroll") for (int a = 0; a < 4; ++a) { const float* wp = WI + (tb + (q0_) + 4 * hh + a) * 8; wv[a][0] = *(const f32x4*)wp; wv[a][1] = *(const f32x4*)(wp + 4); } \
            _Pragma("unroll") for (int ks = 0; ks < 4; ++ks) bfr[ks] = *(const bf16x8*)(KI + ((((tb >> 5) + wave) * 4 + ks) * 64 + lane) * 8); } while (0)
        P2_ROUND_LOADS(t0);
        for (int rd = 0; rd < 4; ++rd) {
            const int q0 = t0 + 8 * rd; const int nk32 = (q0 + 8 + 31) >> 5;
#define P2_TILE_LOAD(dst, kt_) do { _Pragma("unroll") for (int ks = 0; ks < 4; ++ks) dst[ks] = *(const bf16x8*)(KI + ((((tb >> 5) + (size_t)(kt_)) * 4 + ks) * 64 + lane) * 8); } while (0)
#define P2_TILE_COMPUTE(src, kt_) do { f32x16 c0 = {}, c1 = {}; \
                _Pragma("unroll") for (int ks = 0; ks < 4; ++ks) { c0 = __builtin_amdgcn_mfma_f32_32x32x16_bf16(af[0][ks], src[ks], c0, 0, 0, 0); c1 = __builtin_amdgcn_mfma_f32_32x32x16_bf16(af[1][ks], src[ks], c1, 0, 0, 0); } \
                _Pragma("unroll") for (int a = 0; a < 4; ++a) { float s = 0.f; \
                    _Pragma("unroll") for (int hl = 0; hl < 4; ++hl) { s = fma1(wv[a][0][hl], relu_bits(c0[4 * hl + a]), s); s = fma1(wv[a][1][hl], relu_bits(c1[4 * hl + a]), s); } \
                    *((LAS unsigned*)(lds + P2_SC) + (4 * hh + a) * 4096 + (kt_) * 32 + r) = mono_key(s); } } while (0)
            for (int kt = wave;;) {
                { const int kn = kt + 8, kl = kn < nk32 ? kn : kt; P2_TILE_LOAD(nbf, kl); __builtin_amdgcn_sched_barrier(0); P2_TILE_COMPUTE(bfr, kt); kt = kn; }
                if (kt >= nk32) break;
                { const int kn = kt + 8, kl = kn < nk32 ? kn : kt; P2_TILE_LOAD(bfr, kl); __builtin_amdgcn_sched_barrier(0); P2_TILE_COMPUTE(nbf, kt); kt = kn; }
                if (kt >= nk32) break;
            }
#undef P2_TILE_LOAD
#undef P2_TILE_COMPUTE
            if (rd < 3) P2_ROUND_LOADS(q0 + 8);
            __syncthreads();
            if (q0 < 2048) p2a_select_row<false>(lds, wave, lane, q0 + wave, 8 * rd + wave); else p2a_select_row<true>(lds, wave, lane, q0 + wave, 8 * rd + wave);
        }
#undef P2_ROUND_LOADS
    }
    __syncthreads();
    u64* MW = (u64*)(F.ws + WS_MASK) + ((size_t)(b * 128 + g) * 64) * 32;
    const int jmax_c = (t0 + 31) >> 6, jmax_w = 4 * (g >> 3) + 3;
    LAS u64* OUT = (LAS u64*)(lds + P2_SC);
    if (wave < 2) {
        unsigned w32[32];
#pragma unroll
        for (int ql = 0; ql < 32; ++ql) w32[ql] = *((const LAS unsigned*)(lds + P2_ROWB) + (ql * 64 + lane) * 2 + wave);
        bit_transpose32(w32);
        const int x = lane & 31, rr = (x & 3) | ((x >> 3) << 2), h = (x >> 2) & 1, w = 16 * (lane >> 5) + rr;
        LAS unsigned* O32 = (LAS unsigned*)(lds + P2_SC);
#pragma unroll
        for (int jj = 0; jj < 32; ++jj) O32[((32 * wave + jj) * 32 + w) * 2 + h] = w32[jj];
    }
    __syncthreads();
    for (int idx = tid; idx < (jmax_w + 1) * 32; idx += 512) MW[idx] = ((idx >> 5) <= jmax_c) ? OUT[idx] : 0ull;
    __syncthreads();
}
__device__ __forceinline__ void p2a_index(const Args& A, Frame& F) {
    for (int it = F.bx; it < NB * 64; it += F.G) { const int b = it >> 6, y = it & 63; p2a_group(A, F, b, 127 - y); p2a_group(A, F, b, y); }
}

constexpr int SG_WL = 0, SG_VT = 34816, SG_STAT = 69632, SG_BS = 70656, SG_LD = 136;
__device__ __forceinline__ void p2b_sgu(const Args& A, Frame& F) {
    LAS unsigned char* lds = F.lds; const int tid = F.tid, lane = F.lane, wave = F.wave;
    bf16_t* SU = (bf16_t*)(F.ws + WS_SU); const bf16_t* SV = (const bf16_t*)(F.ws + WS_SV); const float* SVST = (const float*)(F.ws + WS_SVST);
    LAS bf16_t* WL = (LAS bf16_t*)(lds + SG_WL); LAS bf16_t* VT = (LAS bf16_t*)(lds + SG_VT); LAS f32x2* ST = (LAS f32x2*)(lds + SG_STAT); LAS float* BS = (LAS float*)(lds + SG_BS);
    const int NIT = NB * 32 * 8, lr = lane & 15, kq = lane >> 4, sl = 16 * wave + lr;
    int g_loaded = -1; f32x4 gam[4][2];
    f32x4 st[4]; u32x4 vv[4]; u32x2 uu[8];
#define SG_LOADS(it_) do { const int g_ = (it_) & 7; const size_t tok0_ = (size_t)((it_) >> 3) * 128; \
        const float* sp_ = SVST + ((tok0_ + (tid >> 2)) * 32 + (tid & 3) * 8) * 2; \
        _Pragma("unroll") for (int j = 0; j < 4; ++j) st[j] = *(const f32x4*)(sp_ + 4 * j); \
        _Pragma("unroll") for (int i = 0; i < 4; ++i) vv[i] = *(const u32x4*)(SV + (tok0_ + sl) * 1024 + g_ * 128 + 8 * (4 * i + kq)); \
        _Pragma("unroll") for (int n = 0; n < 8; ++n) uu[n] = *(const u32x2*)(SU + (tok0_ + sl) * 1024 + g_ * 128 + 4 * kq + 16 * n); } while (0)
    if (F.bx < NIT) SG_LOADS(F.bx);
    for (int it = F.bx; it < NIT; it += F.G) {
        const int g = it & 7; const size_t tok0 = (size_t)(it >> 3) * 128;
        if (g != g_loaded) {
            if (g_loaded >= 0) __syncthreads();
            g_loaded = g;
            if (tid >= 128 && tid < 256) BS[tid - 128] = ((const float*)A.in[6])[g * 128 + (tid - 128)];
            const int t = tid >> 2, s0 = (tid & 3) * 32; const float* wp = ((const float*)A.in[5]) + ((size_t)g * 128 + t) * 128 + s0;
#pragma unroll
            for (int c = 0; c < 4; ++c) { const f32x4 a = *(const f32x4*)(wp + 8 * c), b = *(const f32x4*)(wp + 8 * c + 4); const int s = s0 + 8 * c;
                u32x4 o; o.x = pk2(s + 0 <= t ? a[0] : 0.f, s + 1 <= t ? a[1] : 0.f); o.y = pk2(s + 2 <= t ? a[2] : 0.f, s + 3 <= t ? a[3] : 0.f);
                o.z = pk2(s + 4 <= t ? b[0] : 0.f, s + 5 <= t ? b[1] : 0.f); o.w = pk2(s + 6 <= t ? b[2] : 0.f, s + 7 <= t ? b[3] : 0.f);
                *(LAS u32x4*)(WL + t * SG_LD + s) = o; }
#pragma unroll
            for (int i = 0; i < 4; ++i) { const float* gp = ((const float*)A.in[4]) + g * 128 + 8 * (4 * i + kq); gam[i][0] = *(const f32x4*)gp; gam[i][1] = *(const f32x4*)(gp + 4); }
        }
        { float sm = 0.f, sq = 0.f;
#pragma unroll
          for (int j = 0; j < 4; ++j) { sm += st[j].x + st[j].z; sq += st[j].y + st[j].w; }
          sm += __shfl_xor(sm, 1); sq += __shfl_xor(sq, 1); sm += __shfl_xor(sm, 2); sq += __shfl_xor(sq, 2);
          const float mu = sm * (1.f / 1024.f), var = sq * (1.f / 1024.f) - mu * mu;
          if ((tid & 3) == 0) ST[tid >> 2] = (f32x2){mu, 1.0f / sqrtf(var + EPS)}; }
        u32x4 cv[4]; u32x2 uc[8];
#pragma unroll
        for (int i = 0; i < 4; ++i) cv[i] = vv[i];
#pragma unroll
        for (int n = 0; n < 8; ++n) uc[n] = uu[n];
        if (it + F.G < NIT) SG_LOADS(it + F.G);
        __syncthreads();
        { const f32x2 sv = ST[sl];
#pragma unroll
          for (int i = 0; i < 4; ++i) { const int c = 4 * i + kq; const u32x4 v = cv[i];
            const float x0 = (bf_lo(v.x) - sv.x) * sv.y * gam[i][0][0], x1 = (bf_hi(v.x) - sv.x) * sv.y * gam[i][0][1], x2 = (bf_lo(v.y) - sv.x) * sv.y * gam[i][0][2], x3 = (bf_hi(v.y) - sv.x) * sv.y * gam[i][0][3];
            const float x4 = (bf_lo(v.z) - sv.x) * sv.y * gam[i][1][0], x5 = (bf_hi(v.z) - sv.x) * sv.y * gam[i][1][1], x6 = (bf_lo(v.w) - sv.x) * sv.y * gam[i][1][2], x7 = (bf_hi(v.w) - sv.x) * sv.y * gam[i][1][3];
            LAS bf16_t* vp = VT + (8 * c) * SG_LD + (sl ^ ((c & 3) * 16));
            vp[0 * SG_LD] = (bf16_t)f2bf(x0); vp[1 * SG_LD] = (bf16_t)f2bf(x1); vp[2 * SG_LD] = (bf16_t)f2bf(x2); vp[3 * SG_LD] = (bf16_t)f2bf(x3);
            vp[4 * SG_LD] = (bf16_t)f2bf(x4); vp[5 * SG_LD] = (bf16_t)f2bf(x5); vp[6 * SG_LD] = (bf16_t)f2bf(x6); vp[7 * SG_LD] = (bf16_t)f2bf(x7); } }
        __syncthreads();
        f32x4 acc[8];
#pragma unroll
        for (int n = 0; n < 8; ++n) acc[n] = (f32x4){0.f, 0.f, 0.f, 0.f};
        const int nks = (16 * wave + 15) / 32 + 1;
        for (int ks = 0; ks < nks; ++ks) {
            const bf16x8 a = *(const LAS bf16x8*)(WL + (16 * wave + lr) * SG_LD + 32 * ks + 8 * kq);
#pragma unroll
            for (int n = 0; n < 8; ++n) { const int row = 16 * n + lr; const bf16x8 bv = *(const LAS bf16x8*)(VT + row * SG_LD + ((32 * ks + 8 * kq) ^ (((row >> 3) & 3) * 16)));
                acc[n] = __builtin_amdgcn_mfma_f32_16x16x32_bf16(bv, a, acc[n], 0, 0, 0); }
        }
        { const float bs = BS[sl]; bf16_t* up = SU + (tok0 + sl) * 1024 + g * 128 + 4 * kq;
#pragma unroll
            for (int n = 0; n < 8; ++n) { const u32x2 u = uc[n];
                u32x2 o; o.x = cvt_pk_bf16(bf_lo(u.x) * (acc[n][0] + bs), bf_hi(u.x) * (acc[n][1] + bs)); o.y = cvt_pk_bf16(bf_lo(u.y) * (acc[n][2] + bs), bf_hi(u.y) * (acc[n][3] + bs));
                *(u32x2*)(up + 16 * n) = o; } }
    }
#undef SG_LOADS
    __syncthreads();
}

__device__ __forceinline__ void p2_both(const Args& A, Frame& F) {
    const int cls = (F.bx >> 3) % 3;
    if (cls == 0) p2b_sgu(A, F);
    int it = F.bx;
    if (it < NB * 64) { const int b = it >> 6, y = it & 63;
#pragma nounroll
        for (int k = 0; k < 2; ++k) p2a_group(A, F, b, k ? y : 127 - y);
        it += F.G; }
    if (cls == 1) p2b_sgu(A, F);
    for (; it < NB * 64; it += F.G) { const int b = it >> 6, y = it & 63;
#pragma nounroll
        for (int k = 0; k < 2; ++k) p2a_group(A, F, b, k ? y : 127 - y); }
    if (cls == 2) p2b_sgu(A, F);
}

namespace att {
constexpr float SCALE = 0.08838834764831845f, THR = 8.f;
constexpr int NW = 8, QBLK = 32, KVBLK = 64, QB = NW * QBLK, RS = 1024, DH = 128;
constexpr int SHM_V = KVBLK * DH * 2, SHM_K = KVBLK * DH * 2;
constexpr int ATT_LDS = 2 * SHM_V + 2 * SHM_K + NW * 64 * 4;
typedef __attribute__((address_space(4))) const u64 cu64;
#define KSWZ(row, colB) ((row) * 256 + ((colB) ^ (((row) & 7) << 4)))
#define SBAR() __builtin_amdgcn_sched_barrier(0)
__device__ __forceinline__ int v_st(int k, int c) { const int kk = (k & ~0xC) | ((k & 4) << 1) | ((k & 8) >> 1); return ((kk >> 3) * 4 + (c >> 5)) * 512 + ((kk & 7) * 32 + (c & 31)) * 2; }
__device__ __forceinline__ int v_rd_base(int lane) { return ((lane & 3) << 3) | (((lane >> 2) & 3) << 6) | (((lane >> 4) & 1) << 5) | (((lane >> 5) & 1) << 8); }
constexpr int v_rd_off(int d0, int ks, int half) { return d0 * 512 + ks * 4096 + half * 2048; }
__device__ __forceinline__ int crow(int r, int hi) { return (r & 3) + 8 * (r >> 2) + 4 * hi; }
__device__ __forceinline__ unsigned cvtpk(float lo, float hi) { unsigned r; asm volatile("v_cvt_pk_bf16_f32 %0, %1, %2" : "=v"(r) : "v"(lo), "v"(hi)); return r; }
__device__ __forceinline__ bf16x8 load8(const bf16_t* p) { return *reinterpret_cast<const bf16x8*>(p); }
typedef unsigned u32x16 __attribute__((ext_vector_type(16)));
struct MaskHalf { u32x16 a, b; };
__device__ __forceinline__ void msk_issue(MaskHalf& m, const u64* p) {
    asm volatile("s_load_dwordx16 %0, %2, 0x0\n\ts_load_dwordx16 %1, %2, 0x40" : "=&s"(m.a), "=s"(m.b) : "s"(p) : "memory");
}
__device__ __forceinline__ void msk_wait(MaskHalf& m) { asm volatile("s_waitcnt lgkmcnt(0)" : "+s"(m.a), "+s"(m.b) :: "memory"); }
__device__ __forceinline__ void msk_apply(f32x16& p, const MaskHalf& m) {
    const float NEG = -__builtin_inff();
#pragma unroll
    for (int r = 0; r < 16; ++r) { const u64 w = (r < 8) ? (((u64)m.a[2 * r + 1] << 32) | m.a[2 * r]) : (((u64)m.b[2 * (r - 8) + 1] << 32) | m.b[2 * (r - 8)]);
        asm volatile("v_cndmask_b32_e64 %0, %1, %0, %2" : "+v"(p[r]) : "v"(NEG), "s"(w)); }
}
__device__ __forceinline__ void mask_tile(f32x16& p0, f32x16& p1, const u64* mw) {
    asm volatile("s_nop 15\n\ts_nop 15" : "+v"(p0), "+v"(p1));
    MaskHalf m; msk_issue(m, mw); msk_wait(m); msk_apply(p0, m); msk_issue(m, mw + 16); msk_wait(m); msk_apply(p1, m);
}
__device__ __forceinline__ void partialSM(f32x16& p0, f32x16& p1, float& m_reg, float& mn, float& alpha) {
    float pmax = p0[0]; for (int r = 1; r < 16; ++r) pmax = fmaxf(pmax, p0[r]); for (int r = 0; r < 16; ++r) pmax = fmaxf(pmax, p1[r]);
    { auto rr = __builtin_amdgcn_permlane32_swap(__float_as_uint(pmax), __float_as_uint(pmax), false, false);
      pmax = fmaxf(__uint_as_float(rr[0]), __uint_as_float(rr[1])); }
    constexpr float C2 = 1.4426950408889634f * SCALE;
    if (__builtin_expect(__all((pmax - m_reg) * SCALE <= THR), 1)) { mn = m_reg; alpha = 1.f; }
    else { mn = fmaxf(m_reg, pmax); alpha = __builtin_amdgcn_exp2f((m_reg - mn) * C2); m_reg = mn; }
    const float mnL = -mn * C2;
    for (int r = 0; r < 16; ++r) p0[r] = fmaf(p0[r], C2, mnL); for (int r = 0; r < 16; ++r) p1[r] = fmaf(p1[r], C2, mnL);
    for (int r = 0; r < 16; ++r) p0[r] = __builtin_amdgcn_exp2f(p0[r]);
}
__device__ __forceinline__ void finishSM(f32x16& p0, f32x16& p1, float alpha, float& l_reg, bf16x8& pa0, bf16x8& pa1, bf16x8& pa2, bf16x8& pa3) {
    for (int r = 0; r < 16; ++r) p1[r] = __builtin_amdgcn_exp2f(p1[r]);
    float ps = 0; for (int r = 0; r < 16; ++r) ps += p0[r]; for (int r = 0; r < 16; ++r) ps += p1[r];
    { auto rr = __builtin_amdgcn_permlane32_swap(__float_as_uint(ps), __float_as_uint(ps), false, false);
      ps = __uint_as_float(rr[0]) + __uint_as_float(rr[1]); }
    l_reg = l_reg * alpha + ps;
#define PK4(P, B_, OUT) do { unsigned a0 = cvtpk(P[B_+0], P[B_+1]), a1 = cvtpk(P[B_+2], P[B_+3]);                          \
        unsigned b0 = cvtpk(P[B_+4], P[B_+5]), b1 = cvtpk(P[B_+6], P[B_+7]);                                             \
        auto r0 = __builtin_amdgcn_permlane32_swap(a0, b0, false, false); auto r1 = __builtin_amdgcn_permlane32_swap(a1, b1, false, false); \
        u32x4 w = {r0[0], r1[0], r0[1], r1[1]}; OUT = *reinterpret_cast<bf16x8*>(&w); } while (0)
    PK4(p0, 0, pa0); PK4(p0, 8, pa1); PK4(p1, 0, pa2); PK4(p1, 8, pa3);
#undef PK4
}
template <int KB>
__device__ __forceinline__ void qkt(f32x16& p0, f32x16& p1, const char* K_lds, int r32, int hi, const bf16x8* qr) {
    p0 = f32x16{}; p1 = f32x16{};
    const char* kb[4];
#pragma unroll
    for (int dd = 0; dd < 4; ++dd) kb[dd] = K_lds + KB * SHM_K + KSWZ(r32, (dd * 16 + hi * 8) * 2);
#pragma unroll
    for (int d0 = 0; d0 < 8; ++d0) { const char* a = kb[d0 & 3] + (d0 >> 2) * 128;
        bf16x8 b0 = *reinterpret_cast<const bf16x8*>(a);
        bf16x8 b1 = *reinterpret_cast<const bf16x8*>(a + 32 * 256);
        p0 = __builtin_amdgcn_mfma_f32_32x32x16_bf16(b0, qr[d0], p0, 0, 0, 0);
        p1 = __builtin_amdgcn_mfma_f32_32x32x16_bf16(b1, qr[d0], p1, 0, 0, 0); }
}
#define TRRD(dst, off) asm volatile("ds_read_b64_tr_b16 %0, %1 offset:%2" : "=&v"(dst) : "v"(vb0), "i"(off) : "memory")
#define PV_D0(d0) do { s16x4 l0, l1, l2, l3, h0, h1, h2, h3; constexpr int b_ = VB * SHM_V + v_rd_off(d0, 0, 0); \
        TRRD(l0, b_); TRRD(h0, b_ + 2048); TRRD(l1, b_ + 4096); TRRD(h1, b_ + 6144); TRRD(l2, b_ + 8192); TRRD(h2, b_ + 10240); TRRD(l3, b_ + 12288); TRRD(h3, b_ + 14336); \
        asm volatile("s_waitcnt lgkmcnt(0)" ::: "memory"); SBAR();   \
        o[d0] = __builtin_amdgcn_mfma_f32_32x32x16_bf16(pa0, (bf16x8){l0[0], l0[1], l0[2], l0[3], h0[0], h0[1], h0[2], h0[3]}, o[d0], 0, 0, 0);   \
        o[d0] = __builtin_amdgcn_mfma_f32_32x32x16_bf16(pa1, (bf16x8){l1[0], l1[1], l1[2], l1[3], h1[0], h1[1], h1[2], h1[3]}, o[d0], 0, 0, 0);   \
        o[d0] = __builtin_amdgcn_mfma_f32_32x32x16_bf16(pa2, (bf16x8){l2[0], l2[1], l2[2], l2[3], h2[0], h2[1], h2[2], h2[3]}, o[d0], 0, 0, 0);   \
        o[d0] = __builtin_amdgcn_mfma_f32_32x32x16_bf16(pa3, (bf16x8){l3[0], l3[1], l3[2], l3[3], h3[0], h3[1], h3[2], h3[3]}, o[d0], 0, 0, 0); } while (0)
template <int VB>
__device__ __forceinline__ void pv_tile(f32x16* o, int vb0, bf16x8 pa0, bf16x8 pa1, bf16x8 pa2, bf16x8 pa3) {
    PV_D0(0); PV_D0(1); PV_D0(2); PV_D0(3);
}
template <int VB>
__device__ __forceinline__ void pv_tile_mask(f32x16* o, int vb0, bf16x8 pa0, bf16x8 pa1, bf16x8 pa2, bf16x8 pa3, f32x16& x0, f32x16& x1, const u64* mw) {
    MaskHalf m; msk_issue(m, mw);
    PV_D0(0); PV_D0(1);
    msk_wait(m); msk_apply(x0, m); SBAR();
    msk_issue(m, mw + 16);
    PV_D0(2); PV_D0(3);
    msk_wait(m); msk_apply(x1, m); SBAR();
}
#undef PV_D0
#undef TRRD
struct BlockRef { const bf16_t* Q; const bf16_t* K; const bf16_t* V; bf16_t* O; const u64* MW; int P0; };
struct Seam { bf16x8 qr[8]; bf16x8 st_v0, st_v1, st_k0, st_k1; };
#define ROW(p, k0, rr) ((p) + (size_t)((k0) + (rr)) * RS + sc)
#define VMW() asm volatile("s_waitcnt vmcnt(0)" ::: "memory")
#define VMWN(n) asm volatile("s_waitcnt vmcnt(%0)" :: "i"(n) : "memory")
#define SLOAD_H(Kp, Vp, k0) do { S.st_v0 = load8(ROW(Vp, k0, sr)); S.st_v1 = load8(ROW(Vp, k0, 32 + sr));              \
                         S.st_k0 = load8(ROW(Kp, k0, sr)); S.st_k1 = load8(ROW(Kp, k0, 32 + sr)); } while (0)
#define SWRITE_HK(bf) do { *(bf16x8*)(K_lds + (bf) * SHM_K + kws) = S.st_k0; *(bf16x8*)(K_lds + (bf) * SHM_K + kws + 32 * 256) = S.st_k1; } while (0)
#define SWRITE_HV(bf) do { *(bf16x8*)(V_lds + (bf) * SHM_V + vst0) = S.st_v0; *(bf16x8*)(V_lds + (bf) * SHM_V + vst1) = S.st_v1; } while (0)
#define SWRITE_H(bf) do { SWRITE_HV(bf); SWRITE_HK(bf); } while (0)
__device__ __forceinline__ void prime(const BlockRef& cur, char* lds, Seam& S) {
    const int tid = threadIdx.x, wid = __builtin_amdgcn_readfirstlane(tid >> 6), lane = tid & 63, r32 = lane & 31, hi = lane >> 5;
    const int sr = tid >> 4, sc = (tid & 15) * 8, kws = KSWZ(sr, sc * 2); char* K_lds = lds + 2 * SHM_V;
    for (int d0 = 0; d0 < 8; ++d0) S.qr[d0] = load8(cur.Q + (size_t)(wid * QBLK + r32) * RS + d0 * 16 + hi * 8);
    SLOAD_H(cur.K, cur.V, 0); VMW(); SWRITE_HK(0);
    __syncthreads();
}
__device__ __forceinline__ void block(const BlockRef& cur, const BlockRef& nxt, char* lds, Seam& S) {
    const int tid = threadIdx.x, wid = __builtin_amdgcn_readfirstlane(tid >> 6), lane = tid & 63, r32 = lane & 31, hi = lane >> 5;
    const int NT = (cur.P0 + QB - 1) / KVBLK + 1;
    char* V_lds = lds; char* K_lds = lds + 2 * SHM_V;
    float* ws = (float*)(lds + 2 * SHM_V + 2 * SHM_K) + wid * 64; float* li_l = ws, * al_l = ws + 32;
    float m_reg = -1e30f, l_reg = 0; f32x16 o[4] = {};
    const int sr = tid >> 4, sc = (tid & 15) * 8, vst0 = v_st(sr, sc), vst1 = v_st(32 + sr, sc), kws = KSWZ(sr, sc * 2);
    const int vb0 = (int)(uintptr_t)V_lds + v_rd_base(lane);
    const bf16_t* Kh = cur.K; const bf16_t* Vh = cur.V;
    const u64* mwb = cur.MW + (size_t)wid * (64 * 32);
#define RESC(a) do { if (__any((a) < 1.f)) { if (hi == 0) al_l[r32] = (a); asm volatile("s_waitcnt lgkmcnt(0)" ::: "memory");              \
                     for (int d_ = 0; d_ < 4; ++d_) for (int r = 0; r < 16; ++r) o[d_][r] *= al_l[crow(r, hi)]; } } while (0)
#define KBASE(t) ((t) * KVBLK)
#define MASKT(P0_, P1_, t) mask_tile(P0_, P1_, mwb + (size_t)(t) * 32)
    constexpr int NQL = 8;
#define SEAM_K0() do { VMWN(NQL); SWRITE_HK(0); SBAR(); } while (0)
    f32x16 pA0, pA1, pB0, pB1; float mnA, mnB, alA, alB; bf16x8 pa0, pa1, pa2, pa3;
    SWRITE_HV(0); SBAR();
    if (NT > 1) { SLOAD_H(Kh, Vh, KBASE(1)); }
    SBAR(); qkt<0>(pA0, pA1, K_lds, r32, hi, S.qr);
    MASKT(pA0, pA1, 0); partialSM(pA0, pA1, m_reg, mnA, alA);
    if (NT > 1) { VMW(); SWRITE_H(1); }
    __syncthreads();
#define HALF_STEP(PX0, PX1, mnX, alX, PY0, PY1, alY, t, KB, VB, SB) do {                                                      \
        SBAR(); qkt<KB>(PX0, PX1, K_lds, r32, hi, S.qr);                                             \
        finishSM(PY0, PY1, alY, l_reg, pa0, pa1, pa2, pa3); SBAR();                                                           \
        if ((t) + 1 < NT) { SLOAD_H(Kh, Vh, KBASE((t) + 1)); SBAR(); }                                               \
        pv_tile_mask<VB>(o, vb0, pa0, pa1, pa2, pa3, PX0, PX1, mwb + (size_t)(t) * 32); partialSM(PX0, PX1, m_reg, mnX, alX);                                        \
        __syncthreads();                                                                                                      \
        if ((t) + 1 < NT) { VMW(); SWRITE_H(SB); }                                                                          \
        RESC(alX); __syncthreads(); } while (0)
    for (int t = 1; t + 1 < NT; t += 2) {
        HALF_STEP(pB0, pB1, mnB, alB, pA0, pA1, alA, t, 1, 0, 0);
        HALF_STEP(pA0, pA1, mnA, alA, pB0, pB1, alB, t + 1, 0, 1, 1);
    }
    const bool even = (NT & 1) == 0;
    if (even) { SBAR(); qkt<1>(pB0, pB1, K_lds, r32, hi, S.qr); SBAR(); }
    SLOAD_H(nxt.K, nxt.V, 0); SBAR();
#pragma unroll
    for (int d0 = 0; d0 < 8; ++d0) S.qr[d0] = load8(nxt.Q + (size_t)(wid * QBLK + r32) * RS + d0 * 16 + hi * 8);
    SBAR();
    finishSM(pA0, pA1, alA, l_reg, pa0, pa1, pa2, pa3); SBAR();
    pv_tile<0>(o, vb0, pa0, pa1, pa2, pa3);
    if (even) { MASKT(pB0, pB1, NT - 1); partialSM(pB0, pB1, m_reg, mnB, alB); __syncthreads(); RESC(alB);
        finishSM(pB0, pB1, alB, l_reg, pa0, pa1, pa2, pa3); SBAR(); pv_tile<1>(o, vb0, pa0, pa1, pa2, pa3); }
    SBAR(); SEAM_K0();
    if (hi == 0) li_l[r32] = l_reg; asm volatile("s_waitcnt lgkmcnt(0)" ::: "memory");
    float rli[16];
#pragma unroll
    for (int r = 0; r < 16; ++r) rli[r] = __builtin_amdgcn_rcpf(li_l[crow(r, hi)]);
    bf16_t* Ow = cur.O + (size_t)(wid * QBLK) * RS;
#pragma unroll
    for (int r = 0; r < 16; ++r) { const int orow = crow(r, hi);
#pragma unroll
        for (int d0 = 0; d0 < 4; ++d0) { const float v = o[d0][r] * rli[r];
            const float vn = __shfl_xor(v, 1);
            if ((r32 & 1) == 0) *(unsigned*)(Ow + (size_t)orow * RS + d0 * 32 + r32) = cvtpk(v, vn); } }
    __syncthreads();
#undef RESC
#undef KBASE
#undef MASKT
#undef SEAM_K0
#undef HALF_STEP
}
#undef ROW
#undef VMW
#undef VMWN
#undef SLOAD_H
#undef SWRITE_HK
#undef SWRITE_HV
#undef SWRITE_H
#undef KSWZ
#undef SBAR
}

__device__ __forceinline__ att::BlockRef att_ref(Frame& F, int bh, int qb, size_t obase = WS_Q) {
    const int b = bh >> 3, h = bh & 7; att::BlockRef r;
    bf16_t* Qb = (bf16_t*)(F.ws + WS_Q); const bf16_t* Kb = (const bf16_t*)(F.ws + WS_K); const bf16_t* Vb = (const bf16_t*)(F.ws + WS_V);
    r.Q = Qb + ((size_t)b * SEQ + (size_t)qb * 256) * 1024 + h * 128; r.O = (bf16_t*)(F.ws + obase) + ((size_t)b * SEQ + (size_t)qb * 256) * 1024 + h * 128;
    r.K = Kb + (size_t)b * SEQ * 1024 + h * 128; r.V = Vb + (size_t)b * SEQ * 1024 + h * 128;
    r.MW = (const u64*)(F.ws + WS_MASK) + ((size_t)(b * 128 + qb * 8) * 64) * 32; r.P0 = qb * 256;
    return r;
}
__device__ __forceinline__ void p3_attn(const Args& A, Frame& F, size_t obase = WS_Q) {
    const int G = F.G; int L, stride, limit;
    if (G % 8 == 0) { L = (F.bx & 7) * 64 + (F.bx >> 3); stride = G >> 3; limit = (F.bx & 7) * 64 + 64; } else { L = F.bx; stride = G; limit = 512; }
    if (L >= limit) return;
    int pass = 0;
    att::BlockRef cur = att_ref(F, L >> 3, L & 7, obase);
    att::Seam S;
    att::prime(cur, (char*)F.lds, S);
    for (;;) {
        const bool more_pass = pass == 0, more_item = L + stride < limit, last = !more_pass && !more_item;
        int passn = pass + 1, Ln = L;
        if (!more_pass) { passn = 0; Ln = more_item ? L + stride : L; }
        const att::BlockRef nxt = last ? cur : att_ref(F, Ln >> 3, passn ? 15 - (Ln & 7) : (Ln & 7), obase);
        att::block(cur, nxt, (char*)F.lds, S);
        if (last) break;
        cur = nxt; pass = passn; L = Ln;
    }
}

struct SchedTwo {
    const char* A0; const char* B0; const char* A1; const char* B1; int nM, nN, G, c; size_t tstep;
    __device__ __forceinline__ bool next(int i, pg8::Seg& s) const {
        int pm, pn; if (!pg8::static_tile(i >> 1, G, c, nM, nN, pm, pn)) return false;
        s.pm = pm; s.pn = pn; s.aux = 0;
        if ((i & 1) == 0) { s.A = A0 + (size_t)pm * tstep; s.B = B0 + (size_t)pn * tstep; s.kind = 1; }
        else { s.A = A1 + (size_t)pm * tstep; s.B = B1 + (size_t)pn * tstep; s.kind = 2; }
        return true;
    }
    __device__ __forceinline__ int row(const pg8::Seg&, int) const { return 0; }
};
struct EpiMerge {
    static constexpr bool PERM = true; static constexpr int NST = 16;
    const bf16_t* sga; const bf16_t* sgb; bf16_t* mg;
    __device__ __forceinline__ void mid(f32x4 (&acc)[2][2][4][2], const pg8::Seg& u, int wr, int wc, int fr, int fq) const {
        const int row0 = u.pm * 256 + wr * 64 + fr, col0 = u.pn * 256 + wc * 32 + 8 * fq;
#pragma unroll
        for (int ai = 0; ai < 2; ++ai)
#pragma unroll
            for (int m = 0; m < 4; ++m)
#pragma unroll
                for (int bj = 0; bj < 2; ++bj) { const size_t off = (size_t)(row0 + ai * 128 + m * 16) * 1024 + col0 + bj * 128;
                    const u32x4 a = *(const u32x4*)(sga + off), b = *(const u32x4*)(sgb + off);
                    const unsigned aw[4] = {a.x, a.y, a.z, a.w}, bw[4] = {b.x, b.y, b.z, b.w};
#pragma unroll
                    for (int j = 0; j < 4; ++j) { const float r0 = bf_lo(aw[j]) * __builtin_amdgcn_rcpf(fmaxf(bf_lo(bw[j]), 1e-30f)), r1 = bf_hi(aw[j]) * __builtin_amdgcn_rcpf(fmaxf(bf_hi(bw[j]), 1e-30f));
                        acc[ai][bj][m][j >> 1][(j & 1) * 2] *= r0; acc[ai][bj][m][j >> 1][(j & 1) * 2 + 1] *= r1; } }
    }
    __device__ __forceinline__ void operator()(f32x4 (&acc)[2][2][4][2], const pg8::Seg& u, int wr, int wc, int fr, int fq) const {
        const int row0 = u.pm * 256 + wr * 64 + fr, col0 = u.pn * 256 + wc * 32 + 8 * fq;
#pragma unroll
        for (int ai = 0; ai < 2; ++ai) {
            u32x4 gb[4][2];
#pragma unroll
            for (int m = 0; m < 4; ++m)
#pragma unroll
                for (int bj = 0; bj < 2; ++bj) gb[m][bj] = *(const u32x4*)(sgb + (size_t)(row0 + ai * 128 + m * 16) * 1024 + col0 + bj * 128);
#pragma unroll
            for (int m = 0; m < 4; ++m)
#pragma unroll
                for (int bj = 0; bj < 2; ++bj) { const size_t off = (size_t)(row0 + ai * 128 + m * 16) * 1024 + col0 + bj * 128;
                    const u32x4 b = gb[m][bj]; const unsigned bw[4] = {b.x, b.y, b.z, b.w};
                    f32x4 v0 = acc[ai][bj][m][0], v1 = acc[ai][bj][m][1];
                    v0[0] *= fmaxf(bf_lo(bw[0]), 1e-30f); v0[1] *= fmaxf(bf_hi(bw[0]), 1e-30f); v0[2] *= fmaxf(bf_lo(bw[1]), 1e-30f); v0[3] *= fmaxf(bf_hi(bw[1]), 1e-30f);
                    v1[0] *= fmaxf(bf_lo(bw[2]), 1e-30f); v1[1] *= fmaxf(bf_hi(bw[2]), 1e-30f); v1[2] *= fmaxf(bf_lo(bw[3]), 1e-30f); v1[3] *= fmaxf(bf_hi(bw[3]), 1e-30f);
                    *(u32x4*)(mg + off) = pack8v(v0, v1); } }
    }
};
__device__ __forceinline__ void p4a_merge(const Args& A, Frame& F) {
    SchedTwo S; S.A0 = (const char*)(F.ws + WS_SU); S.B0 = (const char*)(F.ws + WS_WA); S.A1 = (const char*)(F.ws + WS_Q); S.B1 = (const char*)(F.ws + WS_WB);
    S.nM = T / 256; S.nN = D / 256; S.G = F.G; S.c = F.bx; S.tstep = (size_t)256 * D * 2;
    EpiMerge E; E.sga = (const bf16_t*)F.out; E.sgb = (const bf16_t*)((unsigned char*)F.out + 64 * MiB); E.mg = (bf16_t*)(F.ws + WS_MG);
    pg8::gemm_phase<EpiMerge, SchedTwo, false>(F.lds, S, E, D, D, D / 64);
}

struct EpiRes {
    static constexpr bool PERM = true; static constexpr int NST = 16;
    const float* x; bf16_t* h1;
    __device__ __forceinline__ void mid(f32x4 (&)[2][2][4][2], const pg8::Seg&, int, int, int, int) const {}
    __device__ __forceinline__ void operator()(f32x4 (&acc)[2][2][4][2], const pg8::Seg& u, int wr, int wc, int fr, int fq) const {
        const int row0 = u.pm * 256 + wr * 64 + fr, col0 = u.pn * 256 + wc * 32 + 8 * fq;
#pragma unroll
        for (int ai = 0; ai < 2; ++ai) {
            f32x4 xa[4][2][2];
#pragma unroll
            for (int m = 0; m < 4; ++m)
#pragma unroll
                for (int bj = 0; bj < 2; ++bj) { const size_t off = (size_t)(row0 + ai * 128 + m * 16) * 1024 + col0 + bj * 128; xa[m][bj][0] = *(const f32x4*)(x + off); xa[m][bj][1] = *(const f32x4*)(x + off + 4); }
#pragma unroll
            for (int m = 0; m < 4; ++m)
#pragma unroll
                for (int bj = 0; bj < 2; ++bj) { const size_t off = (size_t)(row0 + ai * 128 + m * 16) * 1024 + col0 + bj * 128;
                    *(u32x4*)(h1 + off) = pack8v(xa[m][bj][0] + acc[ai][bj][m][0], xa[m][bj][1] + acc[ai][bj][m][1]); } }
    }
};
__device__ __forceinline__ void p4b_out(const Args& A, Frame& F) {
    SchedDense S; S.A = (const char*)(F.ws + WS_MG); S.B = (const char*)(F.ws + WS_WO); S.nM = T / 256; S.nN = D / 256; S.G = F.G; S.c = F.bx; S.tstepA = (size_t)256 * D * 2; S.tstepB = (size_t)256 * D * 2;
    EpiRes E; E.x = ((const float*)A.in[0]); E.h1 = (bf16_t*)(F.ws + WS_H1);
    pg8::gemm_phase<EpiRes, SchedDense, false>(F.lds, S, E, D, D, D / 64);
}

constexpr int P5_WH = 0, P5_WP = 2064, P5_WL = 36 * P5_WP, P5_RT = 2 * 36 * P5_WP, P5_CNT = P5_RT + 2048, P5_LOG = 0, P5_WC = P5_CNT + 512, P5_G2 = P5_WC + 512;
__device__ __forceinline__ void p5_convert(const Args& A, Frame& F) {
    __syncthreads();
    LAS float* scr = (LAS float*)(F.lds + F.wave * 16384); const int lane = F.lane;
    const int gw = F.bx * NWAVES + F.wave, NGW = F.G * NWAVES;
    bf16_t* WEI = (bf16_t*)(F.ws + WS_WEIN); bf16_t* WEO = (bf16_t*)(F.ws + WS_WEOUT);
    constexpr int I_IN = (D / 64) * (512 / 32), I_OUT = (DEXP / 64) * (D / 32);
    for (int it = gw; it < NEXP * (I_IN + I_OUT); it += NGW) {
        if (it < NEXP * I_IN) { const int e = it / I_IN, r = it % I_IN; transpose_item<2>(((const float*)A.in[15]) + (size_t)e * D * 512, D, 512, 512, WEI + (size_t)e * 512 * D, scr, r, lane, (const float*)A.in[10]); }
        else { const int q = it - NEXP * I_IN, e = q / I_OUT, r = q % I_OUT; transpose_item<0>(((const float*)A.in[16]) + (size_t)e * DEXP * D, DEXP, D, D, WEO + (size_t)e * D * DEXP, scr, r, lane); }
    }
    __syncthreads();
}
__device__ __forceinline__ void p5_route(const Args& A, Frame& F) {
    LAS unsigned char* lds = F.lds; const int tid = F.tid, lane = F.lane, wave = F.wave;
    const bool conv_first = ((F.bx >> 3) & 1) == 0;
    if (conv_first) p5_convert(A, F);
    LAS int* RTe = (LAS int*)(lds + P5_RT); LAS float* RTg = (LAS float*)(lds + P5_RT + 1024); LAS int* LC = (LAS int*)(lds + P5_CNT); LAS int* WC = (LAS int*)(lds + P5_WC);
    unsigned* LIST = (unsigned*)(F.ws + WS_LIST); unsigned* ECNT = (unsigned*)(F.ws + WS_CTL) + CW_ECNT; float* GATEL = (float*)(F.ws + WS_GATEL); float* RSTDL = (float*)(F.ws + WS_RSTDL); LAS float* RSl = (LAS float*)(lds + P5_G2);
    for (int rb = F.bx; rb < T / 128; rb += F.G) {
        for (int i = tid; i < 72 * 128; i += 512) { const int c = i >> 7, off = (i & 127) * 16;
            const u32x4 v = *(const u32x4*)((const unsigned char*)(F.ws + WS_WRT) + (size_t)i * 16);
            *(LAS u32x4*)(lds + (c < 36 ? P5_WH + c * P5_WP : P5_WL + (c - 36) * P5_WP) + off) = v; }
        __syncthreads();
        const int lr = lane & 15, kq = lane >> 4; const size_t row = (size_t)rb * 128 + 16 * wave + lr;
        f32x4 acc[3]; acc[0] = (f32x4){0.f, 0.f, 0.f, 0.f}; acc[1] = acc[0]; acc[2] = acc[0]; float ss = 0.f;
#ifdef P5_DUP_ROWS
        for (int rep = 0; rep < 2; ++rep)
#endif
        {
        const bf16_t* hrow = (const bf16_t*)(F.ws + WS_H1) + row * D + 8 * kq;
        const int n2 = (32 + lr) > 35 ? 35 : (32 + lr);
        const LAS unsigned char* bh0 = lds + P5_WH + lr * P5_WP + 16 * kq; const LAS unsigned char* bh1 = bh0 + 16 * P5_WP; const LAS unsigned char* bh2 = lds + P5_WH + n2 * P5_WP + 16 * kq;
#pragma unroll 1
        for (int hf = 0; hf < 2; ++hf) {
            u32x4 hq[16];
#pragma unroll
            for (int i = 0; i < 16; ++i) hq[i] = *(const u32x4*)(hrow + 32 * (16 * hf + i));
#pragma unroll
            for (int i = 0; i < 16; ++i) { const int ks = 16 * hf + i; const u32x4 hw = hq[i];
                const f32x4 h0 = {bf_lo(hw.x), bf_hi(hw.x), bf_lo(hw.y), bf_hi(hw.y)}, h1 = {bf_lo(hw.z), bf_hi(hw.z), bf_lo(hw.w), bf_hi(hw.w)};
                ss += (h0.x * h0.x + h0.y * h0.y) + (h0.z * h0.z + h0.w * h0.w) + (h1.x * h1.x + h1.y * h1.y) + (h1.z * h1.z + h1.w * h1.w);
                const bf16x8 ahi = __builtin_bit_cast(bf16x8, hw);
                { const bf16x8 wh = *(const LAS bf16x8*)(bh0 + 64 * ks), wl = *(const LAS bf16x8*)(bh0 + 64 * ks + P5_WL);
                  acc[0] = __builtin_amdgcn_mfma_f32_16x16x32_bf16(ahi, wh, acc[0], 0, 0, 0); acc[0] = __builtin_amdgcn_mfma_f32_16x16x32_bf16(ahi, wl, acc[0], 0, 0, 0); }
                { const bf16x8 wh = *(const LAS bf16x8*)(bh1 + 64 * ks), wl = *(const LAS bf16x8*)(bh1 + 64 * ks + P5_WL);
                  acc[1] = __builtin_amdgcn_mfma_f32_16x16x32_bf16(ahi, wh, acc[1], 0, 0, 0); acc[1] = __builtin_amdgcn_mfma_f32_16x16x32_bf16(ahi, wl, acc[1], 0, 0, 0); }
                { const bf16x8 wh = *(const LAS bf16x8*)(bh2 + 64 * ks), wl = *(const LAS bf16x8*)(bh2 + 64 * ks + P5_WL);
                  acc[2] = __builtin_amdgcn_mfma_f32_16x16x32_bf16(ahi, wh, acc[2], 0, 0, 0); acc[2] = __builtin_amdgcn_mfma_f32_16x16x32_bf16(ahi, wl, acc[2], 0, 0, 0); }
            }
        }
        }
#ifdef P5_DUP_ROWS
        ss *= 0.5f; acc[0] = acc[0] * 0.5f; acc[1] = acc[1] * 0.5f; acc[2] = acc[2] * 0.5f;
#endif
        ss += __shfl_xor(ss, 16); ss += __shfl_xor(ss, 32);
        const float rstd = 1.0f / sqrtf(ss * (1.f / D) + EPS);
        __syncthreads();
        LAS float* LOG = (LAS float*)(lds + P5_LOG) + wave * (16 * 48);
#pragma unroll
        for (int ct = 0; ct < 3; ++ct)
#pragma unroll
            for (int r = 0; r < 4; ++r) LOG[(4 * kq + r) * 48 + 16 * ct + lr] = acc[ct][r];
        LDS_WAIT();
        if (lane < 16) {
            float lg[36];
#pragma unroll
            for (int c = 0; c < 36; c += 4) { const f32x4 t = *(const LAS f32x4*)(LOG + lane * 48 + c); lg[c] = t.x; lg[c + 1] = t.y; lg[c + 2] = t.z; lg[c + 3] = t.w; }
#pragma unroll
            for (int c = 0; c < 36; ++c) lg[c] = lg[c] * rstd + ((c < 4) ? ((const float*)A.in[12])[c] : ((const float*)A.in[14])[c - 4]);
            int gs = 0; float gm = lg[0];
#pragma unroll
            for (int c = 1; c < 4; ++c) if (lg[c] > gm) { gm = lg[c]; gs = c; }
            float den = 0.f;
#pragma unroll
            for (int c = 0; c < 4; ++c) den += __expf(lg[c] - gm);
            const float gprob = 1.0f / den;
            float el[8];
#pragma unroll
            for (int i = 0; i < 8; ++i) { el[i] = lg[4 + i];
#pragma unroll
                for (int g = 1; g < 4; ++g) el[i] = (gs == g) ? lg[4 + 8 * g + i] : el[i]; }
            int i1 = 0; float v1 = el[0];
#pragma unroll
            for (int i = 1; i < 8; ++i) if (el[i] > v1) { v1 = el[i]; i1 = i; }
            int i2 = -1; float v2 = -__builtin_inff();
#pragma unroll
            for (int i = 0; i < 8; ++i) if (i != i1 && (i2 < 0 || el[i] > v2)) { v2 = el[i]; i2 = i; }
            const float p2 = 1.0f / (1.0f + __expf(v1 - v2)), p1 = 1.0f - p2; const int lrow = 16 * wave + lane;
            RTe[2 * lrow] = gs * 8 + i1; RTe[2 * lrow + 1] = gs * 8 + i2; RTg[2 * lrow] = gprob * p1; RTg[2 * lrow + 1] = gprob * p2; RSl[lrow] = rstd;
        }
        __syncthreads();
        int e = 0, rank = 0;
        if (tid < 256) { e = RTe[tid];
            for (int ee = 0; ee < 32; ++ee) { const u64 m = __ballot(e == ee); if (lane == 0) WC[wave * 32 + ee] = __builtin_popcountll(m);
                if (e == ee) rank = (int)__builtin_amdgcn_mbcnt_hi((unsigned)(m >> 32), __builtin_amdgcn_mbcnt_lo((unsigned)m, 0u)); } }
        __syncthreads();
        if (tid < 32) { const int c = WC[tid] + WC[32 + tid] + WC[64 + tid] + WC[96 + tid];
            LC[tid] = c ? (int)__hip_atomic_fetch_add(ECNT + tid, (unsigned)c, __ATOMIC_RELAXED, __HIP_MEMORY_SCOPE_AGENT) : 0; }
        __syncthreads();
        if (tid < 256) { int lo = LC[e];
            for (int w = 0; w < 4; ++w) lo += (w < wave) ? WC[w * 32 + e] : 0;
            const unsigned ts = (unsigned)(rb * 128 + (tid >> 1)) * 2u + (tid & 1);
            const size_t at = (size_t)e * T + lo + rank; LIST[at] = ts; GATEL[at] = RTg[tid]; RSTDL[at] = RSl[tid >> 1]; }
        __syncthreads();
    }
    if (!conv_first) p5_convert(A, F);
}
constexpr int P6_TAB = 131072;
struct SchedMoe1 {
    const LAS int* tab; const char* xn2; const char* wein; const unsigned* list; int G, c;
    __device__ __forceinline__ bool next(int i, pg8::Seg& s) const {
        const int ntot = tab[32]; long u;
        if ((G & 7) == 0) { const long U = 2L * ntot, per = (U + 7) >> 3, off = (long)i * (G >> 3) + (c >> 3); u = (c & 7) * per + off; if (off >= per || u >= U) return false; }
        else { u = (long)i * G + c; if (u >= 2L * ntot) return false; }
        const int gt = (int)(u >> 1), pn = (int)(u & 1); int e = 0;
        for (int k = 1; k < 32; ++k) e += (tab[k] <= gt) ? 1 : 0;
        s.pm = gt; s.pn = pn; s.aux = (e << 16) | (gt - tab[e]); s.kind = 3; s.A = xn2; s.B = wein + ((size_t)e * 512 + pn * 256) * D * 2; return true;
    }
    __device__ __forceinline__ int row(const pg8::Seg& s, int R) const {
        const int e = s.aux >> 16, idx = (s.aux & 0xffff) * 256 + R; const int cnt = tab[33 + e];
        const unsigned v = list[(size_t)e * T + (idx < cnt ? idx : 0)];
        return idx < cnt ? (int)(v >> 1) : 0;
    }
};
struct EpiAct {
    static constexpr bool PERM = true; static constexpr int NST = 8;
    bf16_t* act; const LAS int* tab; const unsigned* list; const float* rstd;
    __device__ __forceinline__ void mid(f32x4 (&)[2][2][4][2], const pg8::Seg&, int, int, int, int) const {}
    __device__ __forceinline__ void operator()(f32x4 (&acc)[2][2][4][2], const pg8::Seg& u, int wr, int wc, int fr, int fq) const {
        const int row0 = u.pm * 256 + wr * 64 + fr, col0 = u.pn * 128 + wc * 32 + 8 * fq;
        float rsv[2][4];
#pragma unroll
        for (int ai = 0; ai < 2; ++ai)
#pragma unroll
            for (int m = 0; m < 4; ++m) { const int e = u.aux >> 16, idx = (u.aux & 0xffff) * 256 + ai * 128 + wr * 64 + m * 16 + fr; rsv[ai][m] = (idx < tab[33 + e]) ? rstd[(size_t)e * T + idx] : 0.f; }
#pragma unroll
        for (int ai = 0; ai < 2; ++ai)
#pragma unroll
            for (int m = 0; m < 4; ++m) { f32x4 o0, o1;
                const float rs = rsv[ai][m];
#pragma unroll
                for (int j = 0; j < 4; ++j) { const float g0 = acc[ai][0][m][0][j] * rs, g1 = acc[ai][0][m][1][j] * rs;
                    o0[j] = g0 * fast_sigmoid(g0) * (acc[ai][1][m][0][j] * rs); o1[j] = g1 * fast_sigmoid(g1) * (acc[ai][1][m][1][j] * rs); }
                *(u32x4*)(act + (size_t)(row0 + ai * 128 + m * 16) * DEXP + col0) = pack8v(o0, o1); }
    }
};
struct SchedMoe2 {
    const LAS int* tab; const char* act; const char* weout; int G, c;
    __device__ __forceinline__ bool next(int i, pg8::Seg& s) const {
        const int ntot = tab[32]; long u;
        if ((G & 7) == 0) { const long U = 4L * ntot, per = (U + 7) >> 3, off = (long)i * (G >> 3) + (c >> 3); u = (c & 7) * per + off; if (off >= per || u >= U) return false; }
        else { u = (long)i * G + c; if (u >= 4L * ntot) return false; }
        const int gt = (int)(u >> 2), pn = (int)(u & 3); int e = 0;
        for (int k = 1; k < 32; ++k) e += (tab[k] <= gt) ? 1 : 0;
        s.pm = gt; s.pn = pn; s.aux = (e << 16) | (gt - tab[e]); s.kind = 3; s.A = act + (size_t)gt * 256 * DEXP * 2; s.B = weout + ((size_t)e * D + pn * 256) * DEXP * 2; return true;
    }
    __device__ __forceinline__ int row(const pg8::Seg&, int) const { return 0; }
};
struct EpiMoeOut {
    static constexpr bool PERM = true; static constexpr int NST = 0;
    const LAS int* tab; const unsigned* list; const float* gate; bf16_t* ym;
    __device__ __forceinline__ void mid(f32x4 (&)[2][2][4][2], const pg8::Seg&, int, int, int, int) const {}
    __device__ __forceinline__ void operator()(f32x4 (&acc)[2][2][4][2], const pg8::Seg& u, int wr, int wc, int fr, int fq) const {
        const int e = u.aux >> 16, rtl = u.aux & 0xffff, cnt = tab[33 + e], col0 = u.pn * 256 + wc * 32 + 8 * fq;
        unsigned tsv[2][4]; float gv[2][4];
#pragma unroll
        for (int ai = 0; ai < 2; ++ai)
#pragma unroll
            for (int m = 0; m < 4; ++m) { const int idx = rtl * 256 + ai * 128 + wr * 64 + m * 16 + fr; const bool ok = idx < cnt; const size_t at = (size_t)e * T + (ok ? idx : 0);
                tsv[ai][m] = list[at]; gv[ai][m] = gate[at]; }
#pragma unroll
        for (int ai = 0; ai < 2; ++ai)
#pragma unroll
            for (int m = 0; m < 4; ++m) { const int idx = rtl * 256 + ai * 128 + wr * 64 + m * 16 + fr;
                if (idx < cnt) { const unsigned ts = tsv[ai][m]; const float g = gv[ai][m];
#pragma unroll
                    for (int bj = 0; bj < 2; ++bj) *(u32x4*)(ym + (size_t)ts * D + col0 + bj * 128) = pack8v(acc[ai][bj][m][0] * g, acc[ai][bj][m][1] * g); } }
    }
};
__device__ __forceinline__ void p6_tables(const Args& A, Frame& F) {
    LAS int* tab = (LAS int*)(F.lds + P6_TAB);
    if (F.tid < 64) {
        const unsigned* ECNT = (const unsigned*)(F.ws + WS_CTL) + CW_ECNT;
        const int c = (F.tid < 32) ? (int)__hip_atomic_load(ECNT + F.tid, __ATOMIC_RELAXED, __HIP_MEMORY_SCOPE_AGENT) : 0;
        const int tiles = (c + 255) >> 8; int incl = tiles;
#pragma unroll
        for (int d = 1; d < 32; d <<= 1) { const int t = __shfl_up(incl, d); if (F.lane >= d) incl += t; }
        if (F.tid < 32) { tab[F.tid] = incl - tiles; tab[33 + F.tid] = c; if (F.tid == 31) tab[32] = incl; } }
    __syncthreads();
}
__device__ __forceinline__ void p6a_moe_in(const Args& A, Frame& F) {
    p6_tables(A, F);
    SchedMoe1 S; S.tab = (const LAS int*)(F.lds + P6_TAB); S.xn2 = (const char*)(F.ws + WS_H1); S.wein = (const char*)(F.ws + WS_WEIN); S.list = (const unsigned*)(F.ws + WS_LIST); S.G = F.G; S.c = F.bx;
    EpiAct E; E.act = (bf16_t*)(F.ws + WS_ACT); E.tab = S.tab; E.list = S.list; E.rstd = (const float*)(F.ws + WS_RSTDL);
    pg8::gemm_phase<EpiAct, SchedMoe1, true>(F.lds, S, E, D, D, D / 64);
}
__device__ __forceinline__ void p6b_moe_out(const Args& A, Frame& F) {
    p6_tables(A, F);
    SchedMoe2 S; S.tab = (const LAS int*)(F.lds + P6_TAB); S.act = (const char*)(F.ws + WS_ACT); S.weout = (const char*)(F.ws + WS_WEOUT); S.G = F.G; S.c = F.bx;
    EpiMoeOut E; E.tab = S.tab; E.list = (const unsigned*)(F.ws + WS_LIST); E.gate = (const float*)(F.ws + WS_GATEL); E.ym = (bf16_t*)(F.ws + WS_YM);
    int nt = DEXP / 64; asm volatile("" : "+s"(nt));
    pg8::gemm_phase<EpiMoeOut, SchedMoe2, false>(F.lds, S, E, DEXP, DEXP, nt);
}

__device__ __forceinline__ void p7_final(const Args& A, Frame& F) {
    const int gw = F.bx * NWAVES + F.wave, NGW = F.G * NWAVES, lane = F.lane; const bf16_t* YM = (const bf16_t*)(F.ws + WS_YM);
    f32x4 gq[4];
#pragma unroll
    for (int j = 0; j < 4; ++j) gq[j] = ((const f32x4*)((const float*)A.in[17]) + lane)[64 * j];
    for (int m0 = gw; m0 < T; m0 += 2 * NGW) {
        const int m1 = (m0 + NGW < T) ? m0 + NGW : m0;
        f32x4* hp0 = (f32x4*)(F.out + (size_t)m0 * D) + lane; f32x4* hp1 = (f32x4*)(F.out + (size_t)m1 * D) + lane;
        const u32x2* hb0 = (const u32x2*)((const bf16_t*)(F.ws + WS_H1) + (size_t)m0 * D) + lane; const u32x2* hb1 = (const u32x2*)((const bf16_t*)(F.ws + WS_H1) + (size_t)m1 * D) + lane;
        const u32x2* ya0 = (const u32x2*)(YM + (size_t)(2 * m0) * D) + lane; const u32x2* yb0 = (const u32x2*)(YM + (size_t)(2 * m0 + 1) * D) + lane;
        const u32x2* ya1 = (const u32x2*)(YM + (size_t)(2 * m1) * D) + lane; const u32x2* yb1 = (const u32x2*)(YM + (size_t)(2 * m1 + 1) * D) + lane;
        f32x4 v0[4], v1[4]; u32x2 a0[4], b0[4], a1[4], b1[4], c0[4], c1[4];
#pragma unroll
        for (int j = 0; j < 4; ++j) { c0[j] = hb0[64 * j]; a0[j] = ya0[64 * j]; b0[j] = yb0[64 * j]; c1[j] = hb1[64 * j]; a1[j] = ya1[64 * j]; b1[j] = yb1[64 * j]; }
#pragma unroll
        for (int j = 0; j < 4; ++j) { v0[j] = (f32x4){bf_lo(c0[j].x), bf_hi(c0[j].x), bf_lo(c0[j].y), bf_hi(c0[j].y)}; v1[j] = (f32x4){bf_lo(c1[j].x), bf_hi(c1[j].x), bf_lo(c1[j].y), bf_hi(c1[j].y)}; }
        float s0 = 0.f, s1 = 0.f;
#pragma unroll
        for (int j = 0; j < 4; ++j) {
            v0[j].x += bf_lo(a0[j].x) + bf_lo(b0[j].x); v0[j].y += bf_hi(a0[j].x) + bf_hi(b0[j].x); v0[j].z += bf_lo(a0[j].y) + bf_lo(b0[j].y); v0[j].w += bf_hi(a0[j].y) + bf_hi(b0[j].y);
            v1[j].x += bf_lo(a1[j].x) + bf_lo(b1[j].x); v1[j].y += bf_hi(a1[j].x) + bf_hi(b1[j].x); v1[j].z += bf_lo(a1[j].y) + bf_lo(b1[j].y); v1[j].w += bf_hi(a1[j].y) + bf_hi(b1[j].y);
            s0 += (v0[j].x * v0[j].x + v0[j].y * v0[j].y) + (v0[j].z * v0[j].z + v0[j].w * v0[j].w); s1 += (v1[j].x * v1[j].x + v1[j].y * v1[j].y) + (v1[j].z * v1[j].z + v1[j].w * v1[j].w); }
        const float r0 = 1.0f / sqrtf(wave_sum(s0) * (1.f / D) + EPS), r1 = 1.0f / sqrtf(wave_sum(s1) * (1.f / D) + EPS);
#pragma unroll
        for (int j = 0; j < 4; ++j) { const f32x4 g = gq[j]; hp0[64 * j] = v0[j] * r0 * g; if (m1 != m0) hp1[64 * j] = v1[j] * r1 * g; }
    }
}

constexpr int N_PHASES = 11;
__global__ void __launch_bounds__(NWAVES * 64, 2) mega_fwd(Args A) {
    extern __shared__ __attribute__((aligned(16))) unsigned char lds_raw[];
    Frame F;
    F.lds = (LAS unsigned char*)lds_raw; F.tid = threadIdx.x; F.lane = F.tid & 63; F.wave = __builtin_amdgcn_readfirstlane(F.tid >> 6); F.G = gridDim.x; F.bx = blockIdx.x;
    F.out = A.out; F.ws = A.ws;
    volatile LAS unsigned* MISC = (volatile LAS unsigned*)(F.lds + MISC_OFF);
    if (F.tid < 64) MISC[F.tid] = 0u;
    __builtin_amdgcn_fence(__ATOMIC_ACQUIRE, "agent");
    asm volatile("s_waitcnt vmcnt(0) lgkmcnt(0)" ::: "memory");
    __syncthreads();
    const int lo = A.ph_lo, hi = A.ph_hi;
    XcdBarrier bar; bar.bar = (unsigned*)(F.ws + WS_CTL) + CW_BAR; bar.x = 0; bar.st = MISC + 8;
    if (hi - lo > 1) bar = xcd_barrier_post((unsigned*)(F.ws + WS_CTL) + CW_BAR, MISC + 8);
#ifndef PH_MASK
#define PH_MASK 0x7ff
#endif
#define IN(k) (((PH_MASK >> (k)) & 1) && lo <= (k) && (k) < hi)
#define SEAM(k) do { if (IN(k) && IN((k) + 1)) xcd_barrier(bar); } while (0)
#ifndef DUP_MASK
#define DUP_MASK 0
#endif
#define DUP(k) ((DUP_MASK >> (k)) & 1)
    if (IN(0)) { if (DUP(0)) { p0_prep(A, F); xcd_barrier(bar); } p0_prep(A, F); SEAM(0); }
    if (IN(1)) { if (DUP(1)) { p1_proj(A, F); xcd_barrier(bar); } p1_proj(A, F); SEAM(1); }
    if (IN(2)) {
        if (DUP(2)) { p2a_index(A, F); xcd_barrier(bar); }
        p2_both(A, F);
        SEAM(2); }
    if (IN(3)) {
#ifdef DUP_P3
        p3_attn(A, F, WS_XN1); xcd_barrier(bar);
#endif
        p3_attn(A, F); SEAM(3); }
    if (IN(4)) { if (DUP(4)) { p4a_merge(A, F); xcd_barrier(bar); } p4a_merge(A, F); SEAM(4); }
    if (IN(5)) { if (DUP(5)) { p4b_out(A, F); xcd_barrier(bar); } p4b_out(A, F); SEAM(5); }
    if (IN(6)) { if (DUP(6)) { p5_route(A, F); xcd_barrier(bar); } p5_route(A, F); SEAM(6); }
    if (IN(8)) { if (DUP(8)) { p6a_moe_in(A, F); xcd_barrier(bar); } p6a_moe_in(A, F); SEAM(8); }
    if (IN(9)) { if (DUP(9)) { p6b_moe_out(A, F); xcd_barrier(bar); } p6b_moe_out(A, F); SEAM(9); }
    if (IN(10)) { p7_final(A, F); }
    asm volatile("s_waitcnt vmcnt(0)" ::: "memory"); __syncthreads();
    if (F.tid == 0) { __builtin_amdgcn_fence(__ATOMIC_RELEASE, "agent"); asm volatile("s_waitcnt vmcnt(0)" ::: "memory"); }
#undef IN
#undef SEAM
}

#ifndef MK_N_LAUNCHES
#define MK_N_LAUNCHES 1
#endif
extern "C" void kernel_launch(void* const* d_in, const int* in_sizes, int n_in, void* d_out, int out_size, void* d_ws, size_t ws_size, hipStream_t stream) {
    static int grid = 0;
    if (grid == 0) {
        if (n_in != 18 || in_sizes[0] != T * D || out_size != T * D || ws_size < WS_TOTAL) {
            fprintf(stderr, "kernel_launch: unexpected problem (n_in %d, in0 %d, out %d, ws %zu; need ws >= %zu)\n", n_in, n_in > 0 ? in_sizes[0] : -1, out_size, ws_size, (size_t)WS_TOTAL); grid = -1; return; }
        int dev = 0, cus = 0, per_cu = 0;
        if (hipGetDevice(&dev) != hipSuccess || hipDeviceGetAttribute(&cus, hipDeviceAttributeMultiprocessorCount, dev) != hipSuccess) { grid = -1; return; }
        if (hipFuncSetAttribute((const void*)mega_fwd, hipFuncAttributeMaxDynamicSharedMemorySize, LDS_BYTES) != hipSuccess) { fprintf(stderr, "kernel_launch: hipFuncSetAttribute failed\n"); grid = -1; return; }
        if (hipOccupancyMaxActiveBlocksPerMultiprocessor(&per_cu, (const void*)mega_fwd, NWAVES * 64, LDS_BYTES) != hipSuccess || per_cu < 1) { fprintf(stderr, "kernel_launch: occupancy query says %d blocks per CU\n", per_cu); per_cu = 1; }
        (void)hipGetLastError();
        grid = cus;
    }
    if (grid < 0) return;
    (void)hipMemsetAsync((char*)d_ws + WS_CTL, 0, CTL_ZERO_BYTES, stream);
    Args a{};
    for (int i = 0; i < 18; ++i) a.in[i] = d_in[i];
    a.out = (float*)d_out; a.ws = (unsigned char*)d_ws;
    if (MK_N_LAUNCHES == 1) { a.ph_lo = 0; a.ph_hi = N_PHASES; hipLaunchKernelGGL(mega_fwd, dim3(grid), dim3(NWAVES * 64), LDS_BYTES, stream, a); }
    else for (int p = 0; p < N_PHASES; ++p) { a.ph_lo = p; a.ph_hi = p + 1; hipLaunchKernelGGL(mega_fwd, dim3(grid), dim3(NWAVES * 64), LDS_BYTES, stream, a); }
}
```

```cpp
#include <hip/hip_runtime.h>
#include <cstdio>
#include <cstdint>

#define LAS __attribute__((address_space(3)))
#define GAS __attribute__((address_space(1)))
typedef unsigned short bf16_t;
typedef short bf16x8 __attribute__((ext_vector_type(8)));
typedef short s16x4 __attribute__((ext_vector_type(4)));
typedef float f32x2 __attribute__((ext_vector_type(2)));
typedef float f32x4 __attribute__((ext_vector_type(4)));
typedef float f32x16 __attribute__((ext_vector_type(16)));
typedef unsigned u32x2 __attribute__((ext_vector_type(2)));
typedef unsigned u32x4 __attribute__((ext_vector_type(4)));
typedef unsigned long long u64;

constexpr int NB = 8, SEQ = 4096, D = 1024, T = NB * SEQ;
constexpr int NH = 8, HD = 128, IH = 8, ID = 64, TOPK = 256;
constexpr int NPROJ_SRC = 7752, NPROJ = 7936;
constexpr int NEXP = 32, DEXP = 256, EPG = 8, NGRP = 4;
constexpr float EPS = 1e-6f;
constexpr int SRC_Q = 0, SRC_K = 1024, SRC_V = 2048, SRC_QI = 3072, SRC_KI = 3584, SRC_WI = 3648, SRC_SU = 3656, SRC_SV = 4680, SRC_GA = 5704, SRC_GB = 6728;

constexpr size_t MiB = 1u << 20;
constexpr size_t WS_CTL = 0, CTL_ZERO_BYTES = 32 * 1024;
constexpr size_t WS_WIN = 1 * MiB;
constexpr size_t WS_WA = 17 * MiB, WS_WB = 19 * MiB, WS_WO = 21 * MiB;
constexpr size_t WS_ROPE = 23 * MiB;
constexpr size_t WS_WI = 39 * MiB;
constexpr size_t WS_KI = 40 * MiB;
constexpr size_t WS_SVST = 44 * MiB;
constexpr size_t WS_MASK = 52 * MiB;
constexpr size_t WS_QI = 68 * MiB;
constexpr size_t WS_XN1 = 100 * MiB;
constexpr size_t WS_Q = 164 * MiB;
constexpr size_t WS_K = 228 * MiB;
constexpr size_t WS_V = 292 * MiB;
constexpr size_t WS_SU = 356 * MiB;
constexpr size_t WS_SV = 420 * MiB;
constexpr size_t WS_END = 484 * MiB, WS_TOTAL = 502 * MiB;
constexpr size_t WS_WRT = WS_END;
constexpr size_t WS_RSTD = WS_WI + 512 * 1024;
constexpr size_t WS_H1 = WS_SU;
constexpr size_t WS_GATEL = WS_SVST, WS_RSTDL = WS_SVST + 4 * MiB;
constexpr size_t WS_GATE = WS_WI, WS_LIST = WS_KI, WS_MG = WS_XN1, WS_YM = WS_XN1, WS_XN2 = WS_K, WS_WEOUT = WS_V + 32 * MiB, WS_ACT = WS_SV;
constexpr size_t WS_WEIN_A = WS_ROPE, WS_WEIN_B = 486 * MiB;
constexpr int CW_ECNT = 64;
constexpr int CW_BAR = 4096;
static_assert((CW_BAR + 3456) * 4 <= (int)CTL_ZERO_BYTES && (CW_ECNT + 32) * 4 <= (int)CTL_ZERO_BYTES, "control words outside the zeroed region");

constexpr int LDS_BYTES = 160 * 1024;
constexpr int MISC_OFF = LDS_BYTES - 256;

__device__ __forceinline__ unsigned f2bf(float f) { unsigned u = __builtin_bit_cast(unsigned, f); return (u + 0x7fffu + ((u >> 16) & 1u)) >> 16; }
__device__ __forceinline__ unsigned pk2(float lo, float hi) { return f2bf(lo) | (f2bf(hi) << 16); }
__device__ __forceinline__ unsigned cvt_pk_bf16(float lo, float hi) { unsigned r; asm volatile("v_cvt_pk_bf16_f32 %0, %1, %2" : "=v"(r) : "v"(lo), "v"(hi)); return r; }
__device__ __forceinline__ float bf_lo(unsigned w) { return __builtin_bit_cast(float, w << 16); }
__device__ __forceinline__ float bf_hi(unsigned w) { return __builtin_bit_cast(float, w & 0xffff0000u); }
__device__ __forceinline__ float wave_sum(float v) {
#pragma unroll
    for (int o = 1; o < 64; o <<= 1) v += __shfl_xor(v, o);
    return v;
}
__device__ __forceinline__ float fast_sigmoid(float x) { return __builtin_amdgcn_rcpf(1.0f + __builtin_amdgcn_exp2f(-1.4426950408889634f * x)); }
__device__ __forceinline__ float gelu_tanh(float x) {
    const float u2 = 1.5957691216057308f * (x + 0.044715f * x * x * x);
    return x * fast_sigmoid(u2);
}

#define DPP_STEP(v, ctrl, rmask) ((v) + __builtin_bit_cast(float, __builtin_amdgcn_update_dpp(0, __builtin_bit_cast(int, (v)), (ctrl), (rmask), 0xF, false)))
__device__ __forceinline__ float wave_sum_dpp(float v) {
    v = DPP_STEP(v, 0xB1, 0xF);
    v = DPP_STEP(v, 0x4E, 0xF);
    v = DPP_STEP(v, 0x141, 0xF);
    v = DPP_STEP(v, 0x140, 0xF);
    v = DPP_STEP(v, 0x142, 0xA);
    v = DPP_STEP(v, 0x143, 0xC);
    return __builtin_bit_cast(float, __builtin_amdgcn_readlane(__builtin_bit_cast(int, v), 63));
}
#define LDS_WAIT() asm volatile("s_waitcnt lgkmcnt(0)" ::: "memory")
#define VM_WAIT() asm volatile("s_waitcnt vmcnt(0)" ::: "memory")

#define XB_TMO      128
#define XB_XCNT(j)  (256  + 64 * (j))
#define XB_XSUB(j)  (1280 + 64 * (j))
#define XB_XGEN(j)  (2304 + 64 * (j))
#define XB_TOP      3328
#define XB_TOPGEN   3392
#define XCD_BAR_WORDS 3456
#define XB_SPIN_CAP (1u << 22)
__device__ __forceinline__ unsigned xb_ld(unsigned* p)              { return __hip_atomic_load(p, __ATOMIC_RELAXED, __HIP_MEMORY_SCOPE_AGENT); }
__device__ __forceinline__ unsigned xb_add(unsigned* p, unsigned v) { return __hip_atomic_fetch_add(p, v, __ATOMIC_RELAXED, __HIP_MEMORY_SCOPE_AGENT); }
__device__ __forceinline__ unsigned xb_xcc_id() { return (unsigned)__builtin_amdgcn_s_getreg((3 << 11) | 20) & 0xFu; }
#define XB_SPIN(cond, bar) do { unsigned _sp = 0; while (cond) { __builtin_amdgcn_s_sleep(1); \
    if ((++_sp & 255u) == 0u) { if (xb_ld(&(bar)[XB_TMO])) break; if (_sp > XB_SPIN_CAP) { atomicAdd(&(bar)[XB_TMO], 1u); break; } } } } while (0)
struct XcdBarrier { unsigned* bar; unsigned x; volatile LAS unsigned* st; };
__device__ __forceinline__ XcdBarrier xcd_barrier_post(unsigned* bar, volatile LAS unsigned* st) {
    XcdBarrier b; b.bar = bar; b.x = xb_xcc_id(); b.st = st;
    if (threadIdx.x == 0) (void)xb_add(&bar[XB_XCNT(b.x)], 1u);
    return b;
}
__device__ __forceinline__ void xcd_barrier_complete(unsigned* bar, unsigned x, unsigned& nloc, unsigned& nx) {
    const unsigned G = gridDim.x * gridDim.y * gridDim.z;
    unsigned sum, cnt, mine, sp = 0u;
    for (;;) {
        sum = 0u; cnt = 0u; mine = 0u;
#pragma unroll
        for (unsigned j = 0; j < 16; ++j) { const unsigned c = xb_ld(&bar[XB_XCNT(j)]); sum += c; cnt += (c > 0u) ? 1u : 0u; mine = (j == x) ? c : mine; }
        if (sum == G) break;
        __builtin_amdgcn_s_sleep(1);
        if ((++sp & 255u) == 0u) { if (xb_ld(&bar[XB_TMO])) break; if (sp > XB_SPIN_CAP) { atomicAdd(&bar[XB_TMO], 1u); break; } }
    }
    nloc = mine > 0u ? mine : 1u; nx = cnt > 0u ? cnt : 1u;
}
__device__ __forceinline__ void xcd_barrier(const XcdBarrier& b) {
    asm volatile("s_waitcnt vmcnt(0)" ::: "memory");
    __syncthreads();
    if (threadIdx.x == 0) {
        unsigned* bar = b.bar;
        __builtin_amdgcn_s_waitcnt(0);
        unsigned nloc = b.st[0], nx = b.st[1];
        if (nloc == 0u) { xcd_barrier_complete(bar, b.x, nloc, nx); b.st[0] = nloc; b.st[1] = nx; }
        const unsigned old = xb_add(&bar[XB_XSUB(b.x)], 1u);
        const unsigned gen = old / nloc;
        if (old + 1u == (gen + 1u) * nloc) {
            __builtin_amdgcn_fence(__ATOMIC_RELEASE, "agent");
            asm volatile("s_waitcnt vmcnt(0)" ::: "memory");
            const unsigned og = xb_add(&bar[XB_TOP], 1u);
            const unsigned tg = og / nx;
            if (og + 1u == (tg + 1u) * nx) xb_add(&bar[XB_TOPGEN], 1u);
            else XB_SPIN(xb_ld(&bar[XB_TOPGEN]) == tg, bar);
            __builtin_amdgcn_fence(__ATOMIC_ACQUIRE, "agent");
            xb_add(&bar[XB_XGEN(b.x)], 1u);
            asm volatile("s_waitcnt vmcnt(0)" ::: "memory");
        } else {
            XB_SPIN(xb_ld(&bar[XB_XGEN(b.x)]) == gen, bar);
            __builtin_amdgcn_fence(__ATOMIC_ACQUIRE, "agent");
            asm volatile("s_waitcnt vmcnt(0)" ::: "memory");
        }
    }
    __syncthreads();
}

namespace pg8 {
constexpr int BM = 256, BK = 64, HALF = 128, HTB = HALF * BK * 2, STAGE_BYTES = 8 * HTB, NXCD = 8, WGM = 4;
__host__ __device__ __forceinline__ int lds_byte(int r, int c) { const int st = (r >> 4) * 2 + (c >> 5), rr = r & 15, cc = c & 31, ob = rr * 64 + cc * 2; return st * 1024 + (ob ^ (((ob >> 9) & 1) << 5)); }
__host__ __device__ __forceinline__ void stage_rc(int b, int& R, int& C) { const int st = b / 1024, sb = b % 1024, swz = sb ^ (((sb >> 9) & 1) << 5); R = (st >> 1) * 16 + swz / 64; C = (st & 1) * 32 + (swz % 64) / 2; }
__host__ __device__ __forceinline__ int perm32(int rho) { const int n = rho >> 4, i = rho & 15; return 8 * (i >> 2) + 4 * n + (i & 3); }

struct Seg { const char* A; const char* B; int pm, pn, kind, aux; };

__device__ __forceinline__ bool static_tile(int i, int G, int c, int nM, int nN, int& pm, int& pn) {
    const int nwg = nM * nN; const long L = (long)i * G + c; if (L >= nwg) return false;
    int wgid = (int)L; { const int q = nwg / NXCD, r = nwg % NXCD, xcd = wgid % NXCD, off = wgid / NXCD; wgid = (xcd < r ? xcd * (q + 1) : r * (q + 1) + (xcd - r) * q) + off; }
    const int nig = WGM * nN, gid = wgid / nig, fm = gid * WGM, gsz = (nM - fm) < WGM ? (nM - fm) : WGM;
    pm = fm + ((wgid % nig) % gsz); pn = (wgid % nig) / gsz; return true;
}

template <class Epi, class Sched, bool GATHER>
__device__ __forceinline__ void gemm_phase(LAS unsigned char* lds, const Sched& S, const Epi& E, const int lda, const int ldb, const int nt) {
    const int tid = threadIdx.x, wid = __builtin_amdgcn_readfirstlane(tid >> 6), lane = tid & 63, wr = wid >> 2, wc = wid & 3, fr = lane & 15, fq = lane >> 4;
    unsigned voffA[2][2], nvoffA[2][2], voffB[2]; int RR[2], CC[2];
    const size_t hstepA = (size_t)HALF * lda * 2, hstepB = (size_t)HALF * ldb * 2, kstep = (size_t)(BK * 2);
#pragma unroll
    for (int i = 0; i < 2; ++i) { int R, C; stage_rc(tid * 16 + i * 8192, R, C); RR[i] = R; CC[i] = C; const int Rb = Epi::PERM ? ((R & ~31) + perm32(R & 31)) : R;
        voffA[0][i] = (unsigned)(R * lda + C) * 2u; voffA[1][i] = voffA[0][i] + (unsigned)hstepA; voffB[i] = (unsigned)(Rb * ldb + C) * 2u;
        nvoffA[0][i] = voffA[0][i]; nvoffA[1][i] = voffA[1][i]; }
    const unsigned ldsw = (unsigned)wid * 1024u;
    const int aoff = lds_byte(wr * 64 + fr, fq * 8), boff = lds_byte(wc * 32 + fr, fq * 8);
#define PG8_SA(b, h) (((b) * 2 + (h)) * HTB)
#define PG8_SB(b, h) ((4 + (b) * 2 + (h)) * HTB)
#define PG8_STAGEA(bufoff, gbase, vo) do { _Pragma("unroll") for (int _i = 0; _i < 2; ++_i) \
        __builtin_amdgcn_global_load_lds((const unsigned*)((const char*)(gbase) + (vo)[_i]), (LAS unsigned*)(lds + (bufoff) + ldsw + _i * 8192), 16, 0, 0); } while (0)
#define PG8_STAGEB(bufoff, gbase) do { _Pragma("unroll") for (int _i = 0; _i < 2; ++_i) \
        __builtin_amdgcn_global_load_lds((const unsigned*)((const char*)(gbase) + voffB[_i]), (LAS unsigned*)(lds + (bufoff) + ldsw + _i * 8192), 16, 0, 0); } while (0)
#define PG8_LDA(dst, b, h) do { _Pragma("unroll") for (int m = 0; m < 4; ++m) _Pragma("unroll") for (int k = 0; k < 2; ++k) dst[m][k] = *(const LAS bf16x8*)(lds + PG8_SA(b, h) + aoff + m * 2048 + k * 1024); } while (0)
#define PG8_LDB(dst, b, h) do { _Pragma("unroll") for (int n = 0; n < 2; ++n) _Pragma("unroll") for (int k = 0; k < 2; ++k) dst[n][k] = *(const LAS bf16x8*)(lds + PG8_SB(b, h) + boff + n * 2048 + k * 1024); } while (0)
#define PG8_MMA(ai, bj, At, Bt) do { __builtin_amdgcn_s_setprio(1); _Pragma("unroll") for (int m = 0; m < 4; ++m) _Pragma("unroll") for (int n = 0; n < 2; ++n) _Pragma("unroll") for (int k = 0; k < 2; ++k) \
        acc[ai][bj][m][n] = __builtin_amdgcn_mfma_f32_16x16x32_bf16(Bt[n][k], At[m][k], acc[ai][bj][m][n], 0, 0, 0); __builtin_amdgcn_s_setprio(0); } while (0)
#define PG8_WAIT_V(n) asm volatile("s_waitcnt vmcnt(" #n ")" ::: "memory")
#define PG8_WAIT_VX(relax) do { if constexpr (Epi::NST == 16) asm volatile("s_waitcnt vmcnt(24)\n\ts_cmp_lg_u32 %0, 0\n\ts_cbranch_scc1 .Lpg8w%=\n\ts_waitcnt vmcnt(8)\n.Lpg8w%=:" :: "s"(relax) : "memory", "scc"); \
        else if constexpr (Epi::NST == 8) asm volatile("s_waitcnt vmcnt(16)\n\ts_cmp_lg_u32 %0, 0\n\ts_cbranch_scc1 .Lpg8w%=\n\ts_waitcnt vmcnt(8)\n.Lpg8w%=:" :: "s"(relax) : "memory", "scc"); \
        else PG8_WAIT_V(8); } while (0)
#define PG8_WAIT_L(n) asm volatile("s_waitcnt lgkmcnt(" #n ")" ::: "memory")
#define PG8_BAR __builtin_amdgcn_s_barrier()
#define PG8_SCHED __builtin_amdgcn_sched_barrier(0)
    Seg cur, nxt; int ui = 0;
    if (!S.next(0, cur)) return;
    f32x4 acc[2][2][4][2];
#pragma unroll
    for (int a = 0; a < 2; ++a)
#pragma unroll
        for (int b = 0; b < 2; ++b)
#pragma unroll
            for (int m = 0; m < 4; ++m)
#pragma unroll
                for (int n = 0; n < 2; ++n) acc[a][b][m][n] = (f32x4){0.f, 0.f, 0.f, 0.f};
    bf16x8 At[4][2], B0[2][2], B1[2][2];
    const char* cA = cur.A; const char* cB = cur.B;
    if constexpr (GATHER) {
#pragma unroll
        for (int h = 0; h < 2; ++h)
#pragma unroll
            for (int i = 0; i < 2; ++i) voffA[h][i] = (unsigned)(S.row(cur, RR[i] + HALF * h) * lda + CC[i]) * 2u;
    }
    PG8_STAGEB(PG8_SB(0, 0), cB); PG8_STAGEB(PG8_SB(0, 1), cB + hstepB); PG8_STAGEA(PG8_SA(0, 0), cA, voffA[0]); PG8_STAGEA(PG8_SA(0, 1), cA, voffA[1]);
    if (wr == 1) PG8_BAR;
    PG8_WAIT_V(2); PG8_BAR;
    PG8_STAGEB(PG8_SB(1, 0), cB + kstep); PG8_STAGEA(PG8_SA(1, 0), cA + kstep, voffA[0]); PG8_STAGEB(PG8_SB(1, 1), cB + hstepB + kstep);
    PG8_WAIT_V(6); PG8_BAR;
    for (;;) {
        const bool has_next = S.next(ui + 1, nxt);
        const char* nA = has_next ? nxt.A : cA; const char* nB = has_next ? nxt.B : cB;
        if constexpr (GATHER) {
            if (has_next) {
#pragma unroll
                for (int h = 0; h < 2; ++h)
#pragma unroll
                    for (int i = 0; i < 2; ++i) nvoffA[h][i] = (unsigned)(S.row(nxt, RR[i] + HALF * h) * lda + CC[i]) * 2u;
            } else {
#pragma unroll
                for (int h = 0; h < 2; ++h)
#pragma unroll
                    for (int i = 0; i < 2; ++i) nvoffA[h][i] = voffA[h][i];
            }
        }
        for (int t = 0; t < nt; t += 2) {
            const bool last = (t == nt - 2); const int ax = __builtin_amdgcn_readfirstlane(((t == 0) && (ui > 0) && (cur.kind & 1)) ? 1 : 0);
            const char* a1 = cA + (size_t)(t + 1) * kstep;
            const char* a2 = last ? nA : cA + (size_t)(t + 2) * kstep; const char* b2 = last ? nB : cB + (size_t)(t + 2) * kstep;
            const char* a3 = a2 + kstep; const char* b3 = b2 + kstep;
            unsigned v20, v21, v30, v31, w20, w21;
            if constexpr (GATHER) { v20 = last ? nvoffA[0][0] : voffA[0][0]; v21 = last ? nvoffA[0][1] : voffA[0][1]; w20 = last ? nvoffA[1][0] : voffA[1][0]; w21 = last ? nvoffA[1][1] : voffA[1][1]; }
            else { v20 = voffA[0][0]; v21 = voffA[0][1]; w20 = voffA[1][0]; w21 = voffA[1][1]; }
            v30 = v20; v31 = v21;
            const unsigned vh0[2] = {v20, v21}, vh1[2] = {w20, w21};
            PG8_LDB(B0, 0, 0); PG8_LDB(B1, 0, 1); PG8_SCHED; PG8_LDA(At, 0, 0); PG8_STAGEA(PG8_SA(1, 1), a1, voffA[1]);
            PG8_WAIT_VX(ax); PG8_WAIT_L(0); PG8_BAR; PG8_MMA(0, 0, At, B0); PG8_MMA(0, 1, At, B1); PG8_BAR; PG8_SCHED;
            PG8_LDA(At, 0, 1); PG8_STAGEB(PG8_SB(0, 0), b2); PG8_STAGEB(PG8_SB(0, 1), b2 + hstepB); PG8_STAGEA(PG8_SA(0, 0), a2, vh0);
            PG8_WAIT_VX(ax); PG8_WAIT_L(0); PG8_BAR; PG8_MMA(1, 0, At, B0); PG8_MMA(1, 1, At, B1); PG8_BAR; PG8_SCHED;
            PG8_LDB(B0, 1, 0); PG8_LDB(B1, 1, 1); PG8_SCHED; PG8_LDA(At, 1, 0); PG8_STAGEA(PG8_SA(0, 1), a2, vh1);
            PG8_WAIT_V(8); PG8_WAIT_L(0); PG8_BAR; PG8_MMA(0, 0, At, B0); PG8_MMA(0, 1, At, B1); PG8_BAR; PG8_SCHED;
            PG8_LDA(At, 1, 1); PG8_STAGEB(PG8_SB(1, 0), b3); PG8_STAGEB(PG8_SB(1, 1), b3 + hstepB); PG8_STAGEA(PG8_SA(1, 0), a3, vh0);
            PG8_WAIT_V(8); PG8_WAIT_L(0); PG8_BAR; PG8_MMA(1, 0, At, B0); PG8_MMA(1, 1, At, B1); PG8_BAR; PG8_SCHED;
            (void)v30; (void)v31;
        }
        if (wr == 0) PG8_BAR;
        asm volatile("s_nop 15\n\ts_nop 15" ::: "memory");
        if (cur.kind & 2) E(acc, cur, wr, wc, fr, fq); else E.mid(acc, cur, wr, wc, fr, fq);
        if (!has_next) break;
        if (nxt.kind & 1) {
#pragma unroll
            for (int a = 0; a < 2; ++a)
#pragma unroll
                for (int b = 0; b < 2; ++b)
#pragma unroll
                    for (int m = 0; m < 4; ++m)
#pragma unroll
                        for (int n = 0; n < 2; ++n) acc[a][b][m][n] = (f32x4){0.f, 0.f, 0.f, 0.f};
        }
        cur = nxt; cA = nA; cB = nB; ++ui;
        if constexpr (GATHER) {
#pragma unroll
            for (int h = 0; h < 2; ++h)
#pragma unroll
                for (int i = 0; i < 2; ++i) voffA[h][i] = nvoffA[h][i];
        }
        if (wr == 1) PG8_BAR;
    }
    PG8_WAIT_V(0);
    PG8_BAR;
#undef PG8_SA
#undef PG8_SB
#undef PG8_STAGEA
#undef PG8_STAGEB
#undef PG8_LDA
#undef PG8_LDB
#undef PG8_MMA
#undef PG8_WAIT_V
#undef PG8_WAIT_VX
#undef PG8_WAIT_L
#undef PG8_BAR
#undef PG8_SCHED
}
}

constexpr int NWAVES = 8;
struct Args { const void* in[18]; float* out; unsigned char* ws; int ph_lo, ph_hi; };
struct Frame {
    LAS unsigned char* lds; int tid, lane, wave, G, bx; float* out; unsigned char* ws;
};

__device__ __forceinline__ int win_src(int n) {
    if (n < 2048) { const int seg = n >> 10, h = (n >> 7) & 7, p = n & 127; return seg * 1024 + h * 128 + (p >> 1) + 64 * (p & 1); }
    if (n < 3072) return SRC_V + (n - 2048);
    if (n < 4096) return SRC_SU + (n - 3072);
    if (n < 5120) return SRC_SV + (n - 4096);
    if (n < 6144) return SRC_GA + (n - 5120);
    if (n < 7168) return SRC_GB + (n - 6144);
    if (n < 7680) { const int m = n - 7168, h = m >> 6, p = m & 63; return SRC_QI + h * 64 + (p >> 1) + 32 * (p & 1); }
    if (n < 7744) { const int p = n - 7680; return SRC_KI + (p >> 1) + 32 * (p & 1); }
    if (n < 7752) return SRC_WI + (n - 7744);
    return -1;
}
__device__ __forceinline__ int wein_src(int r) { const int t = r >> 8, q = r & 255; return (q < 128) ? (128 * t + q) : (256 + 128 * t + (q - 128)); }

template <int MAP>
__device__ __forceinline__ void transpose_item(const float* W, int K, int N, int NDEST, bf16_t* WT, LAS float* scr, int item, int lane, const float* kscale = nullptr) {
    const int nblk = NDEST / 32, kb = item / nblk, nb = item % nblk, k0 = 64 * kb, n0 = 32 * nb;
    const int nd = n0 + (lane & 31); int src = nd; if (MAP == 1) src = win_src(nd); if (MAP == 2) src = wein_src(nd);
    float tv[32];
#pragma unroll
    for (int i = 0; i < 32; ++i) { const int kk = 2 * i + (lane >> 5); tv[i] = (src >= 0) ? W[(size_t)(k0 + kk) * N + src] : 0.f; }
#pragma unroll
    for (int i = 0; i < 32; ++i) { const int kk = 2 * i + (lane >> 5); scr[kk * 33 + (lane & 31)] = tv[i]; }
    LDS_WAIT(); asm volatile("" ::: "memory");
    const int c = lane & 7;
    f32x4 q0 = {1.f, 1.f, 1.f, 1.f}, q1 = q0; if (kscale) { q0 = *(const f32x4*)(kscale + k0 + 8 * c); q1 = *(const f32x4*)(kscale + k0 + 8 * c + 4); }
#pragma unroll
    for (int j = 0; j < 4; ++j) { const int n = (lane >> 3) + 8 * j; const LAS float* s = scr + (8 * c) * 33 + n;
        u32x4 o; o.x = pk2(s[0 * 33] * q0[0], s[1 * 33] * q0[1]); o.y = pk2(s[2 * 33] * q0[2], s[3 * 33] * q0[3]); o.z = pk2(s[4 * 33] * q1[0], s[5 * 33] * q1[1]); o.w = pk2(s[6 * 33] * q1[2], s[7 * 33] * q1[3]);
        *(u32x4*)(WT + (size_t)(n0 + n) * K + k0 + 8 * c) = o; }
    LDS_WAIT(); asm volatile("" ::: "memory");
}
struct TItemRegs { float tv[32]; f32x4 q0, q1; };
template <int MAP>
__device__ __forceinline__ void titem_load(TItemRegs& R, const float* W, int N, int NDEST, int item, int lane, const float* kscale) {
    const int nblk = NDEST / 32, kb = item / nblk, nb = item % nblk, k0 = 64 * kb, n0 = 32 * nb;
    const int nd = n0 + (lane & 31); int src = nd; if (MAP == 1) src = win_src(nd); if (MAP == 2) src = wein_src(nd);
#pragma unroll
    for (int i = 0; i < 32; ++i) { const int kk = 2 * i + (lane >> 5); R.tv[i] = (src >= 0) ? W[(size_t)(k0 + kk) * N + src] : 0.f; }
    const int c = lane & 7; R.q0 = (f32x4){1.f, 1.f, 1.f, 1.f}; R.q1 = R.q0;
    if (kscale) { R.q0 = *(const f32x4*)(kscale + k0 + 8 * c); R.q1 = *(const f32x4*)(kscale + k0 + 8 * c + 4); }
}
__device__ __forceinline__ void titem_finish(const TItemRegs& R, int K, int NDEST, bf16_t* WT, LAS float* scr, int item, int lane) {
    const int nblk = NDEST / 32, kb = item / nblk, nb = item % nblk, k0 = 64 * kb, n0 = 32 * nb;
#pragma unroll
    for (int i = 0; i < 32; ++i) { const int kk = 2 * i + (lane >> 5); scr[kk * 33 + (lane & 31)] = R.tv[i]; }
    LDS_WAIT(); asm volatile("" ::: "memory");
    const int c = lane & 7; const f32x4 q0 = R.q0, q1 = R.q1;
#pragma unroll
    for (int j = 0; j < 4; ++j) { const int n = (lane >> 3) + 8 * j; const LAS float* s = scr + (8 * c) * 33 + n;
        u32x4 o; o.x = pk2(s[0 * 33] * q0[0], s[1 * 33] * q0[1]); o.y = pk2(s[2 * 33] * q0[2], s[3 * 33] * q0[3]); o.z = pk2(s[4 * 33] * q1[0], s[5 * 33] * q1[1]); o.w = pk2(s[6 * 33] * q1[2], s[7 * 33] * q1[3]);
        *(u32x4*)(WT + (size_t)(n0 + n) * K + k0 + 8 * c) = o; }
    LDS_WAIT(); asm volatile("" ::: "memory");
}
__device__ __forceinline__ void split_pair(float a, float b, unsigned& hi, unsigned& lo) {
    const unsigned ua = __builtin_bit_cast(unsigned, a), ub = __builtin_bit_cast(unsigned, b);
    hi = (ub & 0xffff0000u) | (ua >> 16);
    lo = cvt_pk_bf16(a - __builtin_bit_cast(float, ua & 0xffff0000u), b - __builtin_bit_cast(float, ub & 0xffff0000u));
}
__device__ __forceinline__ void rms_row_to_bf16(const float* xrow, const float* g, bf16_t* orow, int lane) {
    const f32x4* xr = (const f32x4*)xrow + lane; const f32x4* gr = (const f32x4*)g + lane;
    f32x4 v[4]; float s = 0.f;
#pragma unroll
    for (int j = 0; j < 4; ++j) { v[j] = xr[64 * j]; s += (v[j].x * v[j].x + v[j].y * v[j].y) + (v[j].z * v[j].z + v[j].w * v[j].w); }
    const float rstd = 1.0f / sqrtf(wave_sum(s) * (1.f / D) + EPS);
    u64* o8 = (u64*)orow + lane;
#pragma unroll
    for (int j = 0; j < 4; ++j) { const f32x4 gg = gr[64 * j];
        o8[64 * j] = (u64)pk2(v[j].x * rstd * gg.x, v[j].y * rstd * gg.y) | ((u64)pk2(v[j].z * rstd * gg.z, v[j].w * rstd * gg.w) << 32); }
}
__device__ __forceinline__ void p0_prep(const Args& A, Frame& F) {
    LAS float* scr = (LAS float*)(F.lds + F.wave * 16384);
    const int gw = F.bx * NWAVES + F.wave, NGW = F.G * NWAVES;
    bf16_t* WinT = (bf16_t*)(F.ws + WS_WIN);
    constexpr int I_IN = (D / 64) * (NPROJ / 32);
    if (gw < I_IN) { TItemRegs Ra, Rb; int it = gw;
#define WIN_LOAD(R, it_) titem_load<1>(R, ((const float*)A.in[3]), NPROJ_SRC, NPROJ, (it_) < I_IN ? (it_) : I_IN - 1, F.lane, nullptr)
#define WIN_FIN(R, it_) titem_finish(R, D, NPROJ, WinT, scr, (it_), F.lane)
        WIN_LOAD(Ra, it);
        for (;;) {
            WIN_LOAD(Rb, it + NGW); __builtin_amdgcn_sched_barrier(0); WIN_FIN(Ra, it); it += NGW; if (it >= I_IN) break;
            WIN_LOAD(Ra, it + NGW); __builtin_amdgcn_sched_barrier(0); WIN_FIN(Rb, it); it += NGW; if (it >= I_IN) break;
        }
#undef WIN_LOAD
#undef WIN_FIN
    }
    { unsigned* WIMG = (unsigned*)(F.ws + WS_WRT); const float* g2 = (const float*)A.in[10];
      for (int i = F.bx * 512 + F.tid; i < 36 * 512; i += F.G * 512) { const int c = i >> 9, k = (i & 511) * 2;
          const float w0 = (c < 4) ? ((const float*)A.in[11])[k * 4 + c] : ((const float*)A.in[13])[k * 32 + (c - 4)], w1 = (c < 4) ? ((const float*)A.in[11])[(k + 1) * 4 + c] : ((const float*)A.in[13])[(k + 1) * 32 + (c - 4)];
          unsigned hi, lo; split_pair(w0 * g2[k], w1 * g2[k + 1], hi, lo); WIMG[i] = hi; WIMG[36 * 512 + i] = lo; } }
    bf16_t* XN1 = (bf16_t*)(F.ws + WS_XN1);
    f32x4 g1q[4];
#pragma unroll
    for (int j = 0; j < 4; ++j) g1q[j] = ((const f32x4*)((const float*)A.in[2]) + F.lane)[64 * j];
    for (int m0 = gw; m0 < T; m0 += 2 * NGW) {
        const int m1 = (m0 + NGW < T) ? m0 + NGW : m0;
        const f32x4* x0 = (const f32x4*)(((const float*)A.in[0]) + (size_t)m0 * D) + F.lane; const f32x4* x1 = (const f32x4*)(((const float*)A.in[0]) + (size_t)m1 * D) + F.lane;
        f32x4 v0[4], v1[4]; float s0 = 0.f, s1 = 0.f;
#pragma unroll
        for (int j = 0; j < 4; ++j) { v0[j] = x0[64 * j]; v1[j] = x1[64 * j]; }
#pragma unroll
        for (int j = 0; j < 4; ++j) { s0 += (v0[j].x * v0[j].x + v0[j].y * v0[j].y) + (v0[j].z * v0[j].z + v0[j].w * v0[j].w); s1 += (v1[j].x * v1[j].x + v1[j].y * v1[j].y) + (v1[j].z * v1[j].z + v1[j].w * v1[j].w); }
        const float r0 = 1.0f / sqrtf(wave_sum(s0) * (1.f / D) + EPS), r1 = 1.0f / sqrtf(wave_sum(s1) * (1.f / D) + EPS);
        u64* o0 = (u64*)(XN1 + (size_t)m0 * D) + F.lane; u64* o1 = (u64*)(XN1 + (size_t)m1 * D) + F.lane;
#pragma unroll
        for (int j = 0; j < 4; ++j) { const f32x4 gg = g1q[j];
            o0[64 * j] = (u64)pk2(v0[j].x * r0 * gg.x, v0[j].y * r0 * gg.y) | ((u64)pk2(v0[j].z * r0 * gg.z, v0[j].w * r0 * gg.w) << 32);
            if (m1 != m0) o1[64 * j] = (u64)pk2(v1[j].x * r1 * gg.x, v1[j].y * r1 * gg.y) | ((u64)pk2(v1[j].z * r1 * gg.z, v1[j].w * r1 * gg.w) << 32); }
    }
}


template <int OFF> __device__ __forceinline__ void ald16(f32x4& d, const void* p) { asm volatile("global_load_dwordx4 %0, %1, off offset:%2" : "=v"(d) : "v"(p), "i"(OFF) : "memory"); }
template <int OFF> __device__ __forceinline__ void ald16u(u32x4& d, const void* p) { asm volatile("global_load_dwordx4 %0, %1, off offset:%2" : "=v"(d) : "v"(p), "i"(OFF) : "memory"); }
__device__ __forceinline__ void ald4(unsigned& d, const void* p) { asm volatile("global_load_dword %0, %1, off" : "=v"(d) : "v"(p) : "memory"); }
__device__ __forceinline__ void ald4f(float& d, const void* p) { asm volatile("global_load_dword %0, %1, off" : "=v"(d) : "v"(p) : "memory"); }
#define AWAIT8(a, b, c, d, e, f, g, h) asm volatile("s_waitcnt vmcnt(0)" : "+v"(a), "+v"(b), "+v"(c), "+v"(d), "+v"(e), "+v"(f), "+v"(g), "+v"(h) :: "memory")
#define AWAIT4(a, b, c, d) asm volatile("s_waitcnt vmcnt(0)" : "+v"(a), "+v"(b), "+v"(c), "+v"(d) :: "memory")

struct SchedDense {
    const char* A; const char* B; int nM, nN, G, c; size_t tstepA, tstepB;
    __device__ __forceinline__ bool next(int i, pg8::Seg& s) const {
        int pm, pn; if (!pg8::static_tile(i, G, c, nM, nN, pm, pn)) return false;
        s.pm = pm; s.pn = pn; s.A = A + (size_t)pm * tstepA; s.B = B + (size_t)pn * tstepB; s.kind = 3; s.aux = 0; return true;
    }
    __device__ __forceinline__ int row(const pg8::Seg&, int) const { return 0; }
};

__device__ __forceinline__ u32x4 pack8v(f32x4 a, f32x4 b) { u32x4 w; w.x = cvt_pk_bf16(a[0], a[1]); w.y = cvt_pk_bf16(a[2], a[3]); w.z = cvt_pk_bf16(b[0], b[1]); w.w = cvt_pk_bf16(b[2], b[3]); return w; }
__device__ __forceinline__ void rope4(f32x4& v, f32x4 cs) {
    const float a0 = v[0] * cs[0] - v[1] * cs[1], a1 = v[1] * cs[0] + v[0] * cs[1], b0 = v[2] * cs[2] - v[3] * cs[3], b1 = v[3] * cs[2] + v[2] * cs[3];
    v = (f32x4){a0, a1, b0, b1};
}
__device__ __forceinline__ f32x2 cos_sin(float ang) {
    const float C1 = 0.15915494f, C2 = 6.4206383e-09f;
    const float k = __builtin_floorf(ang * C1); const float r = fmaf(ang, C2, fmaf(ang, C1, -k));
    return (f32x2){__builtin_amdgcn_cosf(r), __builtin_amdgcn_sinf(r)};
}
__device__ __forceinline__ float rope_freq(int entry) { return __builtin_amdgcn_exp2f(-(float)entry * (13.287712379549449f / 64.0f)); }
struct EpiProj {
    static constexpr bool PERM = true; static constexpr int NST = 8;
    unsigned char* ws; unsigned char* outb; const int* pos;
    __device__ __forceinline__ void mid(f32x4 (&)[2][2][4][2], const pg8::Seg&, int, int, int, int) const {}
    __device__ __forceinline__ void operator()(f32x4 (&acc)[2][2][4][2], const pg8::Seg& u, int wr, int wc, int fr, int fq) const {
        const int pn = u.pn, row0 = u.pm * 256 + wr * 64 + fr, cl = wc * 32 + 8 * fq;
        unsigned ps[2][4];
        if (pn < 8 || pn >= 28) {
#pragma unroll
            for (int ai = 0; ai < 2; ++ai)
#pragma unroll
                for (int m = 0; m < 4; ++m) ald4(ps[ai][m], pos + row0 + ai * 128 + m * 16);
            AWAIT8(ps[0][0], ps[0][1], ps[0][2], ps[0][3], ps[1][0], ps[1][1], ps[1][2], ps[1][3]); }
        if (pn < 8) {
            bf16_t* dst = (bf16_t*)(ws + (pn < 4 ? WS_Q : WS_K)) + (pn & 3) * 256 + cl;
            float fr4[4];
#pragma unroll
            for (int j = 0; j < 4; ++j) fr4[j] = rope_freq(16 * wc + 4 * fq + j);
#pragma unroll
            for (int ai = 0; ai < 2; ++ai)
#pragma unroll
                for (int m = 0; m < 4; ++m) { const int row = row0 + ai * 128 + m * 16; const float pf = (float)(int)ps[ai][m];
                    const f32x2 a0 = cos_sin(pf * fr4[0]), a1 = cos_sin(pf * fr4[1]), a2 = cos_sin(pf * fr4[2]), a3 = cos_sin(pf * fr4[3]);
                    const f32x4 c0 = {a0.x, a0.y, a1.x, a1.y}, c1 = {a2.x, a2.y, a3.x, a3.y};
#pragma unroll
                    for (int bj = 0; bj < 2; ++bj) { f32x4 v0 = acc[ai][bj][m][0], v1 = acc[ai][bj][m][1]; rope4(v0, c0); rope4(v1, c1);
                        *(u32x4*)(dst + (size_t)row * 1024 + bj * 128) = pack8v(v0, v1); } }
        } else if (pn < 28) {
            const int kind = (pn - 8) >> 2;
            bf16_t* dst;
            if (kind == 0) dst = (bf16_t*)(ws + WS_V); else if (kind == 1) dst = (bf16_t*)(ws + WS_SU); else if (kind == 2) dst = (bf16_t*)(ws + WS_SV);
            else if (kind == 3) dst = (bf16_t*)outb; else dst = (bf16_t*)(outb + 64 * MiB);
            dst += (pn & 3) * 256 + cl;
            f32x2* SVST = (f32x2*)(ws + WS_SVST);
#pragma unroll
            for (int ai = 0; ai < 2; ++ai)
#pragma unroll
                for (int m = 0; m < 4; ++m) { const int row = row0 + ai * 128 + m * 16;
#pragma unroll
                    for (int bj = 0; bj < 2; ++bj) { f32x4 v0 = acc[ai][bj][m][0], v1 = acc[ai][bj][m][1];
                        if (kind == 1 || kind == 2) {
#pragma unroll
                            for (int j = 0; j < 4; ++j) { v0[j] = gelu_tanh(v0[j]); v1[j] = gelu_tanh(v1[j]); } }
                        if (kind >= 3) {
#pragma unroll
                            for (int j = 0; j < 4; ++j) { v0[j] = fast_sigmoid(v0[j]); v1[j] = fast_sigmoid(v1[j]); } }
                        if (kind == 2) { float s = (v0[0] + v0[1]) + (v0[2] + v0[3]) + (v1[0] + v1[1]) + (v1[2] + v1[3]);
                            float q = (v0[0] * v0[0] + v0[1] * v0[1]) + (v0[2] * v0[2] + v0[3] * v0[3]) + (v1[0] * v1[0] + v1[1] * v1[1]) + (v1[2] * v1[2] + v1[3] * v1[3]);
                            s += __shfl_xor(s, 16); s += __shfl_xor(s, 32); q += __shfl_xor(q, 16); q += __shfl_xor(q, 32);
                            if (fq == 0) SVST[(size_t)row * 32 + (pn & 3) * 8 + bj * 4 + wc] = (f32x2){s, q}; }
                        *(u32x4*)(dst + (size_t)row * 1024 + bj * 128) = pack8v(v0, v1); } }
        } else {
            float fr4[4];
#pragma unroll
            for (int j = 0; j < 4; ++j) fr4[j] = rope_freq(32 * (wc & 1) + 8 * fq + 2 * j);
#pragma unroll
            for (int ai = 0; ai < 2; ++ai)
#pragma unroll
                for (int m = 0; m < 4; ++m) { const int row = row0 + ai * 128 + m * 16; const float pf = (float)(int)ps[ai][m];
                    const f32x2 a0 = cos_sin(pf * fr4[0]), a1 = cos_sin(pf * fr4[1]), a2 = cos_sin(pf * fr4[2]), a3 = cos_sin(pf * fr4[3]);
                    const f32x4 c0 = {a0.x, a0.y, a1.x, a1.y}, c1 = {a2.x, a2.y, a3.x, a3.y};
#pragma unroll
                    for (int bj = 0; bj < 2; ++bj) { f32x4 v0 = acc[ai][bj][m][0], v1 = acc[ai][bj][m][1];
                        if (pn < 30) { rope4(v0, c0); rope4(v1, c1); *(u32x4*)((bf16_t*)(ws + WS_QI) + (size_t)row * 512 + (pn - 28) * 256 + bj * 128 + cl) = pack8v(v0, v1); }
                        else if (bj == 0) {
                            if (wc < 2) { rope4(v0, c0); rope4(v1, c1); const int c8 = cl >> 3; *(u32x4*)((bf16_t*)(ws + WS_KI) + ((((size_t)row >> 5) * 4 + (c8 >> 1)) * 64 + (row & 31) + 32 * (c8 & 1)) * 8) = pack8v(v0, v1); }
                            else if (wc == 2 && fq == 0) { float* wi = (float*)(ws + WS_WI) + (size_t)row * 8; *(f32x4*)wi = v0; *(f32x4*)(wi + 4) = v1; } } } }
        }
    }
};
__device__ __forceinline__ void convert_wein(const Args& A, Frame& F, int gw, int NGW);
__device__ __forceinline__ void convert_sq(const Args& A, Frame& F, int gw, int NGW);
__device__ __forceinline__ void p1_proj(const Args& A, Frame& F) {
    SchedDense S; S.A = (const char*)(F.ws + WS_XN1); S.B = (const char*)(F.ws + WS_WIN); S.nM = T / 256; S.nN = NPROJ / 256; S.G = F.G; S.c = F.bx; S.tstepA = (size_t)256 * D * 2; S.tstepB = (size_t)256 * D * 2;
    EpiProj E; E.ws = F.ws; E.outb = (unsigned char*)F.out; E.pos = (const int*)A.in[1];
    pg8::gemm_phase<EpiProj, SchedDense, false>(F.lds, S, E, D, D, D / 64);
    { const int nwg = S.nM * S.nN, first = nwg % F.G;
      if (F.bx >= first) { asm volatile("s_waitcnt vmcnt(0)" ::: "memory"); convert_wein(A, F, (F.bx - first) * NWAVES + F.wave, (F.G - first) * NWAVES); convert_sq(A, F, (F.bx - first) * NWAVES + F.wave, (F.G - first) * NWAVES); } }
}

constexpr int P2_SC = 0, P2_ROWB = 131072, P2_HIST = 147456;
__device__ __forceinline__ float fma1(float a, float b, float c) { float d; asm("v_fma_f32 %0, %1, %2, %3" : "=v"(d) : "v"(a), "v"(b), "v"(c)); return d; }
__device__ __forceinline__ float relu_bits(float x) { const int i = __builtin_bit_cast(int, x); return __builtin_bit_cast(float, i > 0 ? i : 0); }
__device__ __forceinline__ unsigned mono_key(float f) { const unsigned u = __builtin_bit_cast(unsigned, f); return u ^ ((u >> 31) ? 0xffffffffu : 0x80000000u); }

__device__ __forceinline__ int wave_isum_dpp(int v) {
#define IDPP(v, ctrl, rmask) ((v) + __builtin_amdgcn_update_dpp(0, (v), (ctrl), (rmask), 0xF, false))
    v = IDPP(v, 0xB1, 0xF); v = IDPP(v, 0x4E, 0xF); v = IDPP(v, 0x141, 0xF); v = IDPP(v, 0x140, 0xF); v = IDPP(v, 0x142, 0xA); v = IDPP(v, 0x143, 0xC);
#undef IDPP
    return __builtin_amdgcn_readlane(v, 63);
}
__device__ __forceinline__ void wave_isum2_dpp(int& a, int& b) {
#define IDPP(v, ctrl, rmask) ((v) + __builtin_amdgcn_update_dpp(0, (v), (ctrl), (rmask), 0xF, false))
    a = IDPP(a, 0xB1, 0xF); b = IDPP(b, 0xB1, 0xF); a = IDPP(a, 0x4E, 0xF); b = IDPP(b, 0x4E, 0xF); a = IDPP(a, 0x141, 0xF); b = IDPP(b, 0x141, 0xF);
    a = IDPP(a, 0x140, 0xF); b = IDPP(b, 0x140, 0xF); a = IDPP(a, 0x142, 0xA); b = IDPP(b, 0x142, 0xA); a = IDPP(a, 0x143, 0xC); b = IDPP(b, 0x143, 0xC);
#undef IDPP
    a = __builtin_amdgcn_readlane(a, 63); b = __builtin_amdgcn_readlane(b, 63);
}
__device__ __forceinline__ void bit_transpose32(unsigned (&w)[32]) {
#pragma unroll
    for (int k = 0; k < 32; ++k) if (!(k & 16)) { const unsigned a = w[k], b = w[k + 16]; w[k] = __builtin_amdgcn_perm(b, a, 0x05040100u); w[k + 16] = __builtin_amdgcn_perm(b, a, 0x07060302u); }
#pragma unroll
    for (int k = 0; k < 32; ++k) if (!(k & 8)) { const unsigned a = w[k], b = w[k + 8]; w[k] = __builtin_amdgcn_perm(b, a, 0x06020400u); w[k + 8] = __builtin_amdgcn_perm(b, a, 0x07030501u); }
#pragma unroll
    for (int st = 0; st < 3; ++st) { const int j = 4 >> st; const unsigned m = (st == 0) ? 0x0F0F0F0Fu : (st == 1) ? 0x33333333u : 0x55555555u;
#pragma unroll
        for (int k = 0; k < 32; ++k) if (!(k & j)) { const unsigned a = w[k], b = w[k + j]; w[k] = (a & m) | ((b << j) & ~m); w[k + j] = ((a >> j) & m) | (b & ~m); } }
}
template <bool HI>
__device__ __forceinline__ void p2a_select_row(LAS unsigned char* lds, int wave, int lane, int q, int rowslot) {
    const LAS unsigned* sc = (const LAS unsigned*)(lds + P2_SC) + wave * 4096;
    unsigned lo[32], hi[32];
#pragma unroll
    for (int i = 0; i < 32; ++i) { lo[i] = sc[i * 64 + lane]; hi[i] = HI ? sc[(32 + i) * 64 + lane] : 0u; }
    __syncthreads();
    const int nv = ((q - lane) >> 6) + 1;
    unsigned Alo = nv >= 32 ? 0xffffffffu : ((1u << nv) - 1u), Ahi = (HI && nv > 32) ? (nv >= 64 ? 0xffffffffu : ((1u << (nv - 32)) - 1u)) : 0u;
    bit_transpose32(lo); if (HI) bit_transpose32(hi);
    unsigned Glo = 0u, Ghi = 0u; int above = 0, alive = q + 1;
    bool live = true;
#define P2_STEP(b) if (live) { if (above + alive == TOPK) live = false; else {     \
        const unsigned p1l = lo[b], p1h = hi[b], p0l = lo[b - 1], p0h = hi[b - 1]; \
        const unsigned a1l = Alo & p1l, a1h = Ahi & p1h, S3l = a1l & p0l, S3h = a1h & p0h, S2l = a1l ^ S3l, S2h = a1h ^ S3h; \
        const unsigned a0l = Alo ^ a1l, a0h = Ahi ^ a1h, S1l = a0l & p0l, S1h = a0h & p0h; \
        int x = (__builtin_popcount(S3l) + __builtin_popcount(S3h)) | ((__builtin_popcount(S2l) + __builtin_popcount(S2h)) << 16), y = __builtin_popcount(S1l) + __builtin_popcount(S1h); \
        wave_isum2_dpp(x, y); \
        const int C3 = x & 0xffff, C2 = x >> 16, C1 = y; \
        if (above + C3 >= TOPK) { Alo = S3l; Ahi = S3h; alive = C3; } \
        else if (above + C3 + C2 >= TOPK) { above += C3; Glo |= S3l; Ghi |= S3h; Alo = S2l; Ahi = S2h; alive = C2; } \
        else if (above + C3 + C2 + C1 >= TOPK) { above += C3 + C2; Glo |= a1l; Ghi |= a1h; Alo = S1l; Ahi = S1h; alive = C1; } \
        else { above += C3 + C2 + C1; Glo |= a1l | S1l; Ghi |= a1h | S1h; Alo = a0l ^ S1l; Ahi = a0h ^ S1h; alive -= C3 + C2 + C1; } } }
    P2_STEP(31) P2_STEP(29) P2_STEP(27) P2_STEP(25) P2_STEP(23) P2_STEP(21) P2_STEP(19) P2_STEP(17) P2_STEP(15) P2_STEP(13) P2_STEP(11) P2_STEP(9) P2_STEP(7) P2_STEP(5) P2_STEP(3) P2_STEP(1)
#undef P2_STEP
    const int need = TOPK - above, eqtot = alive;
    unsigned Tlo = Alo, Thi = Ahi;
    if (eqtot != need) {
        int rem = need; Tlo = 0u; Thi = 0u;
#pragma unroll
        for (int j = 0; j < (HI ? 64 : 32); ++j) { const bool eq = (((j < 32 ? Alo : Ahi) >> (j & 31)) & 1u) != 0u; const u64 e = __ballot(eq);
            const int rank = (int)__builtin_amdgcn_mbcnt_hi((unsigned)(e >> 32), __builtin_amdgcn_mbcnt_lo((unsigned)e, 0u));
            if (eq && rank < rem) { if (j < 32) Tlo |= 1u << (j & 31); else Thi |= 1u << (j & 31); }
            rem -= __builtin_popcountll(e); }
    }
    *((LAS u32x2*)(lds + P2_ROWB) + rowslot * 64 + lane) = (u32x2){Glo | Tlo, Ghi | Thi};
}

__device__ __forceinline__ void p2a_group(const Args& A, Frame& F, int b, int g) {
    LAS unsigned char* lds = F.lds; const int lane = F.lane, wave = F.wave, tid = F.tid;
    const int t0 = 32 * g; const size_t tb = (size_t)b * SEQ;
    const bf16_t* QI = (const bf16_t*)(F.ws + WS_QI); const bf16_t* KI = (const bf16_t*)(F.ws + WS_KI); const float* WI = (const float*)(F.ws + WS_WI);
    if (g < 8) {
        for (int idx = tid; idx < 32 * 64; idx += 512) { const int ql = idx >> 6, ln = idx & 63, t = t0 + ql; const int n = (t >= ln) ? ((t - ln) >> 6) + 1 : 0;
            const u64 w = (n >= 64) ? ~0ull : ((1ull << n) - 1ull);
            *((LAS u64*)(lds + P2_ROWB) + ql * 64 + ln) = w; }
    } else {
        const int r = lane & 31, hh = lane >> 5;
        bf16x8 af[2][4]; f32x4 wv[4][2]; bf16x8 bfr[4], nbf[4];
#define P2_ROUND_LOADS(q0_) do { \
            _Pragma("unroll") for (int mt = 0; mt < 2; ++mt) _Pragma("unroll") for (int ks = 0; ks < 4; ++ks) af[mt][ks] = *(const bf16x8*)(QI + (tb + (q0_) + (r & 7)) * 512 + (4 * mt + (r >> 3)) * 64 + 16 * ks + 8 * hh); \
            _Pragma("unroll") for (int a = 0; a < 4; ++a) { const float* wp = WI + (tb + (q0_) + 4 * hh + a) * 8; wv[a][0] = *(const f32x4*)wp; wv[a][1] = *(const f32x4*)(wp + 4); } \
            _Pragma("unroll") for (int ks = 0; ks < 4; ++ks) bfr[ks] = *(const bf16x8*)(KI + ((((tb >> 5) + wave) * 4 + ks) * 64 + lane) * 8); } while (0)
        P2_ROUND_LOADS(t0);
        for (int rd = 0; rd < 4; ++rd) {
            const int q0 = t0 + 8 * rd; const int nk32 = (q0 + 8 + 31) >> 5;
#define P2_TILE_LOAD(dst, kt_) do { _Pragma("unroll") for (int ks = 0; ks < 4; ++ks) dst[ks] = *(const bf16x8*)(KI + ((((tb >> 5) + (size_t)(kt_)) * 4 + ks) * 64 + lane) * 8); } while (0)
#define P2_TILE_COMPUTE(src, kt_) do { f32x16 c0 = {}, c1 = {}; \
                _Pragma("unroll") for (int ks = 0; ks < 4; ++ks) { c0 = __builtin_amdgcn_mfma_f32_32x32x16_bf16(af[0][ks], src[ks], c0, 0, 0, 0); c1 = __builtin_amdgcn_mfma_f32_32x32x16_bf16(af[1][ks], src[ks], c1, 0, 0, 0); } \
                _Pragma("unroll") for (int a = 0; a < 4; ++a) { float s = 0.f; \
                    _Pragma("unroll") for (int hl = 0; hl < 4; ++hl) { s = fma1(wv[a][0][hl], relu_bits(c0[4 * hl + a]), s); s = fma1(wv[a][1][hl], relu_bits(c1[4 * hl + a]), s); } \
                    *((LAS unsigned*)(lds + P2_SC) + (4 * hh + a) * 4096 + (kt_) * 32 + r) = mono_key(s); } } while (0)
            for (int kt = wave;;) {
                { const int kn = kt + 8, kl = kn < nk32 ? kn : kt; P2_TILE_LOAD(nbf, kl); __builtin_amdgcn_sched_barrier(0); P2_TILE_COMPUTE(bfr, kt); kt = kn; }
                if (kt >= nk32) break;
                { const int kn = kt + 8, kl = kn < nk32 ? kn : kt; P2_TILE_LOAD(bfr, kl); __builtin_amdgcn_sched_barrier(0); P2_TILE_COMPUTE(nbf, kt); kt = kn; }
                if (kt >= nk32) break;
            }
#undef P2_TILE_LOAD
#undef P2_TILE_COMPUTE
            if (rd < 3) P2_ROUND_LOADS(q0 + 8);
            __syncthreads();
            if (q0 < 2048) p2a_select_row<false>(lds, wave, lane, q0 + wave, 8 * rd + wave); else p2a_select_row<true>(lds, wave, lane, q0 + wave, 8 * rd + wave);
        }
#undef P2_ROUND_LOADS
    }
    __syncthreads();
    u64* MW = (u64*)(F.ws + WS_MASK) + ((size_t)(b * 128 + g) * 64) * 32;
    const int jmax_c = (t0 + 31) >> 6, jmax_w = 4 * (g >> 3) + 3;
    LAS u64* OUT = (LAS u64*)(lds + P2_SC);
    if (wave < 2) {
        unsigned w32[32];
#pragma unroll
        for (int ql = 0; ql < 32; ++ql) w32[ql] = *((const LAS unsigned*)(lds + P2_ROWB) + (ql * 64 + lane) * 2 + wave);
        bit_transpose32(w32);
        const int x = lane & 31, rr = (x & 3) | ((x >> 3) << 2), h = (x >> 2) & 1, w = 16 * (lane >> 5) + rr;
        LAS unsigned* O32 = (LAS unsigned*)(lds + P2_SC);
#pragma unroll
        for (int jj = 0; jj < 32; ++jj) O32[((32 * wave + jj) * 32 + w) * 2 + h] = w32[jj];
    }
    __syncthreads();
    for (int idx = tid; idx < (jmax_w + 1) * 32; idx += 512) MW[idx] = ((idx >> 5) <= jmax_c) ? OUT[idx] : 0ull;
    __syncthreads();
}
__device__ __forceinline__ void p2a_index(const Args& A, Frame& F) {
    for (int it = F.bx; it < NB * 64; it += F.G) { const int b = it >> 6, y = it & 63; p2a_group(A, F, b, 127 - y); p2a_group(A, F, b, y); }
}

constexpr int SG_WL = 0, SG_VT = 34816, SG_STAT = 69632, SG_BS = 70656, SG_LD = 136;
__device__ __forceinline__ void p2b_sgu(const Args& A, Frame& F) {
    LAS unsigned char* lds = F.lds; const int tid = F.tid, lane = F.lane, wave = F.wave;
    bf16_t* SU = (bf16_t*)(F.ws + WS_SU); const bf16_t* SV = (const bf16_t*)(F.ws + WS_SV); const float* SVST = (const float*)(F.ws + WS_SVST);
    LAS bf16_t* WL = (LAS bf16_t*)(lds + SG_WL); LAS bf16_t* VT = (LAS bf16_t*)(lds + SG_VT); LAS f32x2* ST = (LAS f32x2*)(lds + SG_STAT); LAS float* BS = (LAS float*)(lds + SG_BS);
    const int NIT = NB * 32 * 8, lr = lane & 15, kq = lane >> 4, sl = 16 * wave + lr;
    int g_loaded = -1; f32x4 gam[4][2];
    f32x4 st[4]; u32x4 vv[4]; u32x2 uu[8];
#define SG_LOADS(it_) do { const int g_ = (it_) & 7; const size_t tok0_ = (size_t)((it_) >> 3) * 128; \
        const float* sp_ = SVST + ((tok0_ + (tid >> 2)) * 32 + (tid & 3) * 8) * 2; \
        _Pragma("unroll") for (int j = 0; j < 4; ++j) st[j] = *(const f32x4*)(sp_ + 4 * j); \
        _Pragma("unroll") for (int i = 0; i < 4; ++i) vv[i] = *(const u32x4*)(SV + (tok0_ + sl) * 1024 + g_ * 128 + 8 * (4 * i + kq)); \
        _Pragma("unroll") for (int n = 0; n < 8; ++n) uu[n] = *(const u32x2*)(SU + (tok0_ + sl) * 1024 + g_ * 128 + 4 * kq + 16 * n); } while (0)
    if (F.bx < NIT) SG_LOADS(F.bx);
    for (int it = F.bx; it < NIT; it += F.G) {
        const int g = it & 7; const size_t tok0 = (size_t)(it >> 3) * 128;
        if (g != g_loaded) {
            if (g_loaded >= 0) __syncthreads();
            g_loaded = g;
            if (tid >= 128 && tid < 256) BS[tid - 128] = ((const float*)A.in[6])[g * 128 + (tid - 128)];
            const int t = tid >> 2, s0 = (tid & 3) * 32; const float* wp = ((const float*)A.in[5]) + ((size_t)g * 128 + t) * 128 + s0;
#pragma unroll
            for (int c = 0; c < 4; ++c) { const f32x4 a = *(const f32x4*)(wp + 8 * c), b = *(const f32x4*)(wp + 8 * c + 4); const int s = s0 + 8 * c;
                u32x4 o; o.x = pk2(s + 0 <= t ? a[0] : 0.f, s + 1 <= t ? a[1] : 0.f); o.y = pk2(s + 2 <= t ? a[2] : 0.f, s + 3 <= t ? a[3] : 0.f);
                o.z = pk2(s + 4 <= t ? b[0] : 0.f, s + 5 <= t ? b[1] : 0.f); o.w = pk2(s + 6 <= t ? b[2] : 0.f, s + 7 <= t ? b[3] : 0.f);
                *(LAS u32x4*)(WL + t * SG_LD + s) = o; }
#pragma unroll
            for (int i = 0; i < 4; ++i) { const float* gp = ((const float*)A.in[4]) + g * 128 + 8 * (4 * i + kq); gam[i][0] = *(const f32x4*)gp; gam[i][1] = *(const f32x4*)(gp + 4); }
        }
        { float sm = 0.f, sq = 0.f;
#pragma unroll
          for (int j = 0; j < 4; ++j) { sm += st[j].x + st[j].z; sq += st[j].y + st[j].w; }
          sm += __shfl_xor(sm, 1); sq += __shfl_xor(sq, 1); sm += __shfl_xor(sm, 2); sq += __shfl_xor(sq, 2);
          const float mu = sm * (1.f / 1024.f), var = sq * (1.f / 1024.f) - mu * mu;
          if ((tid & 3) == 0) ST[tid >> 2] = (f32x2){mu, 1.0f / sqrtf(var + EPS)}; }
        u32x4 cv[4]; u32x2 uc[8];
#pragma unroll
        for (int i = 0; i < 4; ++i) cv[i] = vv[i];
#pragma unroll
        for (int n = 0; n < 8; ++n) uc[n] = uu[n];
        if (it + F.G < NIT) SG_LOADS(it + F.G);
        __syncthreads();
        { const f32x2 sv = ST[sl];
#pragma unroll
          for (int i = 0; i < 4; ++i) { const int c = 4 * i + kq; const u32x4 v = cv[i];
            const float x0 = (bf_lo(v.x) - sv.x) * sv.y * gam[i][0][0], x1 = (bf_hi(v.x) - sv.x) * sv.y * gam[i][0][1], x2 = (bf_lo(v.y) - sv.x) * sv.y * gam[i][0][2], x3 = (bf_hi(v.y) - sv.x) * sv.y * gam[i][0][3];
            const float x4 = (bf_lo(v.z) - sv.x) * sv.y * gam[i][1][0], x5 = (bf_hi(v.z) - sv.x) * sv.y * gam[i][1][1], x6 = (bf_lo(v.w) - sv.x) * sv.y * gam[i][1][2], x7 = (bf_hi(v.w) - sv.x) * sv.y * gam[i][1][3];
            LAS bf16_t* vp = VT + (8 * c) * SG_LD + (sl ^ ((c & 3) * 16));
            vp[0 * SG_LD] = (bf16_t)f2bf(x0); vp[1 * SG_LD] = (bf16_t)f2bf(x1); vp[2 * SG_LD] = (bf16_t)f2bf(x2); vp[3 * SG_LD] = (bf16_t)f2bf(x3);
            vp[4 * SG_LD] = (bf16_t)f2bf(x4); vp[5 * SG_LD] = (bf16_t)f2bf(x5); vp[6 * SG_LD] = (bf16_t)f2bf(x6); vp[7 * SG_LD] = (bf16_t)f2bf(x7); } }
        __syncthreads();
        f32x4 acc[8];
#pragma unroll
        for (int n = 0; n < 8; ++n) acc[n] = (f32x4){0.f, 0.f, 0.f, 0.f};
        const int nks = (16 * wave + 15) / 32 + 1;
        for (int ks = 0; ks < nks; ++ks) {
            const bf16x8 a = *(const LAS bf16x8*)(WL + (16 * wave + lr) * SG_LD + 32 * ks + 8 * kq);
#pragma unroll
            for (int n = 0; n < 8; ++n) { const int row = 16 * n + lr; const bf16x8 bv = *(const LAS bf16x8*)(VT + row * SG_LD + ((32 * ks + 8 * kq) ^ (((row >> 3) & 3) * 16)));
                acc[n] = __builtin_amdgcn_mfma_f32_16x16x32_bf16(bv, a, acc[n], 0, 0, 0); }
        }
        { const float bs = BS[sl]; bf16_t* up = SU + (tok0 + sl) * 1024 + g * 128 + 4 * kq;
#pragma unroll
            for (int n = 0; n < 8; ++n) { const u32x2 u = uc[n];
                u32x2 o; o.x = cvt_pk_bf16(bf_lo(u.x) * (acc[n][0] + bs), bf_hi(u.x) * (acc[n][1] + bs)); o.y = cvt_pk_bf16(bf_lo(u.y) * (acc[n][2] + bs), bf_hi(u.y) * (acc[n][3] + bs));
                *(u32x2*)(up + 16 * n) = o; } }
    }
#undef SG_LOADS
    __syncthreads();
}

__device__ __forceinline__ void p2_both(const Args& A, Frame& F) {
    const int cls = (F.bx >> 3) % 3;
    if (cls == 0) p2b_sgu(A, F);
    int it = F.bx;
    if (it < NB * 64) { const int b = it >> 6, y = it & 63;
#pragma nounroll
        for (int k = 0; k < 2; ++k) p2a_group(A, F, b, k ? y : 127 - y);
        it += F.G; }
    if (cls == 1) p2b_sgu(A, F);
    for (; it < NB * 64; it += F.G) { const int b = it >> 6, y = it & 63;
#pragma nounroll
        for (int k = 0; k < 2; ++k) p2a_group(A, F, b, k ? y : 127 - y); }
    if (cls == 2) p2b_sgu(A, F);
}

namespace att {
constexpr float SCALE = 0.08838834764831845f, THR = 8.f;
constexpr int NW = 8, QBLK = 32, KVBLK = 64, QB = NW * QBLK, RS = 1024, DH = 128;
constexpr int SHM_V = KVBLK * DH * 2, SHM_K = KVBLK * DH * 2;
constexpr int ATT_LDS = 2 * SHM_V + 2 * SHM_K + NW * 64 * 4;
typedef __attribute__((address_space(4))) const u64 cu64;
#define KSWZ(row, colB) ((row) * 256 + ((colB) ^ (((row) & 7) << 4)))
#define SBAR() __builtin_amdgcn_sched_barrier(0)
__device__ __forceinline__ int v_st(int k, int c) { const int kk = (k & ~0xC) | ((k & 4) << 1) | ((k & 8) >> 1); return ((kk >> 3) * 4 + (c >> 5)) * 512 + ((kk & 7) * 32 + (c & 31)) * 2; }
__device__ __forceinline__ int v_rd_base(int lane) { return ((lane & 3) << 3) | (((lane >> 2) & 3) << 6) | (((lane >> 4) & 1) << 5) | (((lane >> 5) & 1) << 8); }
constexpr int v_rd_off(int d0, int ks, int half) { return d0 * 512 + ks * 4096 + half * 2048; }
__device__ __forceinline__ int crow(int r, int hi) { return (r & 3) + 8 * (r >> 2) + 4 * hi; }
__device__ __forceinline__ unsigned cvtpk(float lo, float hi) { unsigned r; asm volatile("v_cvt_pk_bf16_f32 %0, %1, %2" : "=v"(r) : "v"(lo), "v"(hi)); return r; }
__device__ __forceinline__ bf16x8 load8(const bf16_t* p) { return *reinterpret_cast<const bf16x8*>(p); }
typedef unsigned u32x16 __attribute__((ext_vector_type(16)));
struct MaskHalf { u32x16 a, b; };
__device__ __forceinline__ void msk_issue(MaskHalf& m, const u64* p) {
    asm volatile("s_load_dwordx16 %0, %2, 0x0\n\ts_load_dwordx16 %1, %2, 0x40" : "=&s"(m.a), "=s"(m.b) : "s"(p) : "memory");
}
__device__ __forceinline__ void msk_wait(MaskHalf& m) { asm volatile("s_waitcnt lgkmcnt(0)" : "+s"(m.a), "+s"(m.b) :: "memory"); }
__device__ __forceinline__ void msk_apply(f32x16& p, const MaskHalf& m) {
    const float NEG = -__builtin_inff();
#pragma unroll
    for (int r = 0; r < 16; ++r) { const u64 w = (r < 8) ? (((u64)m.a[2 * r + 1] << 32) | m.a[2 * r]) : (((u64)m.b[2 * (r - 8) + 1] << 32) | m.b[2 * (r - 8)]);
        asm volatile("v_cndmask_b32_e64 %0, %1, %0, %2" : "+v"(p[r]) : "v"(NEG), "s"(w)); }
}
__device__ __forceinline__ void mask_tile(f32x16& p0, f32x16& p1, const u64* mw) {
    asm volatile("s_nop 15\n\ts_nop 15" : "+v"(p0), "+v"(p1));
    MaskHalf m; msk_issue(m, mw); msk_wait(m); msk_apply(p0, m); msk_issue(m, mw + 16); msk_wait(m); msk_apply(p1, m);
}
__device__ __forceinline__ void partialSM(f32x16& p0, f32x16& p1, float& m_reg, float& mn, float& alpha) {
    float pmax = p0[0]; for (int r = 1; r < 16; ++r) pmax = fmaxf(pmax, p0[r]); for (int r = 0; r < 16; ++r) pmax = fmaxf(pmax, p1[r]);
    { auto rr = __builtin_amdgcn_permlane32_swap(__float_as_uint(pmax), __float_as_uint(pmax), false, false);
      pmax = fmaxf(__uint_as_float(rr[0]), __uint_as_float(rr[1])); }
    constexpr float C2 = 1.4426950408889634f * SCALE;
    if (__builtin_expect(__all((pmax - m_reg) * SCALE <= THR), 1)) { mn = m_reg; alpha = 1.f; }
    else { mn = fmaxf(m_reg, pmax); alpha = __builtin_amdgcn_exp2f((m_reg - mn) * C2); m_reg = mn; }
    const float mnL = -mn * C2;
    for (int r = 0; r < 16; ++r) p0[r] = fmaf(p0[r], C2, mnL); for (int r = 0; r < 16; ++r) p1[r] = fmaf(p1[r], C2, mnL);
    for (int r = 0; r < 16; ++r) p0[r] = __builtin_amdgcn_exp2f(p0[r]);
}
__device__ __forceinline__ void finishSM(f32x16& p0, f32x16& p1, float alpha, float& l_reg, bf16x8& pa0, bf16x8& pa1, bf16x8& pa2, bf16x8& pa3) {
    for (int r = 0; r < 16; ++r) p1[r] = __builtin_amdgcn_exp2f(p1[r]);
    float ps = 0; for (int r = 0; r < 16; ++r) ps += p0[r]; for (int r = 0; r < 16; ++r) ps += p1[r];
    { auto rr = __builtin_amdgcn_permlane32_swap(__float_as_uint(ps), __float_as_uint(ps), false, false);
      ps = __uint_as_float(rr[0]) + __uint_as_float(rr[1]); }
    l_reg = l_reg * alpha + ps;
#define PK4(P, B_, OUT) do { unsigned a0 = cvtpk(P[B_+0], P[B_+1]), a1 = cvtpk(P[B_+2], P[B_+3]);                          \
        unsigned b0 = cvtpk(P[B_+4], P[B_+5]), b1 = cvtpk(P[B_+6], P[B_+7]);                                             \
        auto r0 = __builtin_amdgcn_permlane32_swap(a0, b0, false, false); auto r1 = __builtin_amdgcn_permlane32_swap(a1, b1, false, false); \
        u32x4 w = {r0[0], r1[0], r0[1], r1[1]}; OUT = *reinterpret_cast<bf16x8*>(&w); } while (0)
    PK4(p0, 0, pa0); PK4(p0, 8, pa1); PK4(p1, 0, pa2); PK4(p1, 8, pa3);
#undef PK4
}
template <int KB>
__device__ __forceinline__ void qkt(f32x16& p0, f32x16& p1, const char* K_lds, int r32, int hi, const bf16x8* qr) {
    p0 = f32x16{}; p1 = f32x16{};
    const char* kb[4];
#pragma unroll
    for (int dd = 0; dd < 4; ++dd) kb[dd] = K_lds + KB * SHM_K + KSWZ(r32, (dd * 16 + hi * 8) * 2);
#pragma unroll
    for (int d0 = 0; d0 < 8; ++d0) { const char* a = kb[d0 & 3] + (d0 >> 2) * 128;
        bf16x8 b0 = *reinterpret_cast<const bf16x8*>(a);
        bf16x8 b1 = *reinterpret_cast<const bf16x8*>(a + 32 * 256);
        p0 = __builtin_amdgcn_mfma_f32_32x32x16_bf16(b0, qr[d0], p0, 0, 0, 0);
        p1 = __builtin_amdgcn_mfma_f32_32x32x16_bf16(b1, qr[d0], p1, 0, 0, 0); }
}
#define TRRD(dst, off) asm volatile("ds_read_b64_tr_b16 %0, %1 offset:%2" : "=&v"(dst) : "v"(vb0), "i"(off) : "memory")
#define PV_D0H(d0, HOOK) do { s16x4 l0, l1, l2, l3, h0, h1, h2, h3; constexpr int b_ = VB * SHM_V + v_rd_off(d0, 0, 0); \
        TRRD(l0, b_); TRRD(h0, b_ + 2048); TRRD(l1, b_ + 4096); TRRD(h1, b_ + 6144); TRRD(l2, b_ + 8192); TRRD(h2, b_ + 10240); TRRD(l3, b_ + 12288); TRRD(h3, b_ + 14336); \
        asm volatile("s_waitcnt lgkmcnt(0)" ::: "memory"); HOOK; SBAR();   \
        o[d0] = __builtin_amdgcn_mfma_f32_32x32x16_bf16(pa0, (bf16x8){l0[0], l0[1], l0[2], l0[3], h0[0], h0[1], h0[2], h0[3]}, o[d0], 0, 0, 0);   \
        o[d0] = __builtin_amdgcn_mfma_f32_32x32x16_bf16(pa1, (bf16x8){l1[0], l1[1], l1[2], l1[3], h1[0], h1[1], h1[2], h1[3]}, o[d0], 0, 0, 0);   \
        o[d0] = __builtin_amdgcn_mfma_f32_32x32x16_bf16(pa2, (bf16x8){l2[0], l2[1], l2[2], l2[3], h2[0], h2[1], h2[2], h2[3]}, o[d0], 0, 0, 0);   \
        o[d0] = __builtin_amdgcn_mfma_f32_32x32x16_bf16(pa3, (bf16x8){l3[0], l3[1], l3[2], l3[3], h3[0], h3[1], h3[2], h3[3]}, o[d0], 0, 0, 0); } while (0)
#define PV_D0(d0) PV_D0H(d0, (void)0)
template <int VB>
__device__ __forceinline__ void pv_tile(f32x16* o, int vb0, bf16x8 pa0, bf16x8 pa1, bf16x8 pa2, bf16x8 pa3) {
    PV_D0(0); PV_D0(1); PV_D0(2); PV_D0(3);
}
template <int VB>
__device__ __forceinline__ void pv_tile_mask(f32x16* o, int vb0, bf16x8 pa0, bf16x8 pa1, bf16x8 pa2, bf16x8 pa3, f32x16& x0, f32x16& x1, const u64* mw) {
    MaskHalf m;
    PV_D0H(0, msk_issue(m, mw)); PV_D0(1);
    msk_wait(m); msk_apply(x0, m); SBAR();
    PV_D0H(2, msk_issue(m, mw + 16)); PV_D0(3);
    msk_wait(m); msk_apply(x1, m); SBAR();
}
#undef PV_D0
#undef PV_D0H
#undef TRRD
struct BlockRef { const bf16_t* Q; const bf16_t* K; const bf16_t* V; bf16_t* O; const u64* MW; int P0; };
struct Seam { bf16x8 qr[8]; bf16x8 st_v0, st_v1, st_k0, st_k1; };
#define ROW(p, k0, rr) ((p) + (size_t)((k0) + (rr)) * RS + sc)
#define VMW() asm volatile("s_waitcnt vmcnt(0)" ::: "memory")
#define VMWN(n) asm volatile("s_waitcnt vmcnt(%0)" :: "i"(n) : "memory")
#define SLOAD_H(Kp, Vp, k0) do { S.st_v0 = load8(ROW(Vp, k0, sr)); S.st_v1 = load8(ROW(Vp, k0, 32 + sr));              \
                         S.st_k0 = load8(ROW(Kp, k0, sr)); S.st_k1 = load8(ROW(Kp, k0, 32 + sr)); } while (0)
#define SWRITE_HK(bf) do { *(bf16x8*)(K_lds + (bf) * SHM_K + kws) = S.st_k0; *(bf16x8*)(K_lds + (bf) * SHM_K + kws + 32 * 256) = S.st_k1; } while (0)
#define SWRITE_HV(bf) do { *(bf16x8*)(V_lds + (bf) * SHM_V + vst0) = S.st_v0; *(bf16x8*)(V_lds + (bf) * SHM_V + vst1) = S.st_v1; } while (0)
#define SWRITE_H(bf) do { SWRITE_HV(bf); SWRITE_HK(bf); } while (0)
__device__ __forceinline__ void prime(const BlockRef& cur, char* lds, Seam& S) {
    const int tid = threadIdx.x, wid = __builtin_amdgcn_readfirstlane(tid >> 6), lane = tid & 63, r32 = lane & 31, hi = lane >> 5;
    const int sr = tid >> 4, sc = (tid & 15) * 8, kws = KSWZ(sr, sc * 2); char* K_lds = lds + 2 * SHM_V;
    for (int d0 = 0; d0 < 8; ++d0) S.qr[d0] = load8(cur.Q + (size_t)(wid * QBLK + r32) * RS + d0 * 16 + hi * 8);
    SLOAD_H(cur.K, cur.V, 0); VMW(); SWRITE_HK(0);
    __syncthreads();
}
__device__ __forceinline__ void block(const BlockRef& cur, const BlockRef& nxt, char* lds, Seam& S) {
    const int tid = threadIdx.x, wid = __builtin_amdgcn_readfirstlane(tid >> 6), lane = tid & 63, r32 = lane & 31, hi = lane >> 5;
    const int NT = (cur.P0 + QB - 1) / KVBLK + 1;
    char* V_lds = lds; char* K_lds = lds + 2 * SHM_V;
    float* ws = (float*)(lds + 2 * SHM_V + 2 * SHM_K) + wid * 64; float* li_l = ws, * al_l = ws + 32;
    float m_reg = -1e30f, l_reg = 0; f32x16 o[4] = {};
    const int sr = tid >> 4, sc = (tid & 15) * 8, vst0 = v_st(sr, sc), vst1 = v_st(32 + sr, sc), kws = KSWZ(sr, sc * 2);
    const int vb0 = (int)(uintptr_t)V_lds + v_rd_base(lane);
    const bf16_t* Kh = cur.K; const bf16_t* Vh = cur.V;
    const u64* mwb = cur.MW + (size_t)wid * (64 * 32);
#define RESC(a) do { if (__any((a) < 1.f)) { if (hi == 0) al_l[r32] = (a); asm volatile("s_waitcnt lgkmcnt(0)" ::: "memory");              \
                     for (int d_ = 0; d_ < 4; ++d_) for (int r = 0; r < 16; ++r) o[d_][r] *= al_l[crow(r, hi)]; } } while (0)
#define KBASE(t) ((t) * KVBLK)
#define MASKT(P0_, P1_, t) mask_tile(P0_, P1_, mwb + (size_t)(t) * 32)
    constexpr int NQL = 8;
#define SEAM_K0() do { VMWN(NQL); SWRITE_HK(0); SBAR(); } while (0)
    f32x16 pA0, pA1, pB0, pB1; float mnA, mnB, alA, alB; bf16x8 pa0, pa1, pa2, pa3;
    SWRITE_HV(0); SBAR();
    if (NT > 1) { SLOAD_H(Kh, Vh, KBASE(1)); }
    SBAR(); qkt<0>(pA0, pA1, K_lds, r32, hi, S.qr);
    MASKT(pA0, pA1, 0); partialSM(pA0, pA1, m_reg, mnA, alA);
    if (NT > 1) { VMW(); SWRITE_H(1); }
    __syncthreads();
#define SGB(mask, n) __builtin_amdgcn_sched_group_barrier(mask, n, 0)
#define QK_SM_SCHED() do { SGB(0x100, 4); _Pragma("unroll") for (int i_ = 0; i_ < 16; ++i_) { SGB(0x008, 1); SGB(0x100, 1); SGB(0x402, 5); } } while (0)
#define HALF_STEP(PX0, PX1, mnX, alX, PY0, PY1, alY, t, KB, VB, SB) do {                                                      \
        SBAR(); qkt<KB>(PX0, PX1, K_lds, r32, hi, S.qr);                                             \
        finishSM(PY0, PY1, alY, l_reg, pa0, pa1, pa2, pa3); QK_SM_SCHED(); SBAR();                                            \
        if ((t) + 1 < NT) { SLOAD_H(Kh, Vh, KBASE((t) + 1)); SBAR(); }                                               \
        pv_tile_mask<VB>(o, vb0, pa0, pa1, pa2, pa3, PX0, PX1, mwb + (size_t)(t) * 32); partialSM(PX0, PX1, m_reg, mnX, alX);                                        \
        __syncthreads();                                                                                                      \
        if ((t) + 1 < NT) { VMW(); SWRITE_H(SB); }                                                                          \
        RESC(alX); __syncthreads(); } while (0)
    for (int t = 1; t + 1 < NT; t += 2) {
        HALF_STEP(pB0, pB1, mnB, alB, pA0, pA1, alA, t, 1, 0, 0);
        HALF_STEP(pA0, pA1, mnA, alA, pB0, pB1, alB, t + 1, 0, 1, 1);
    }
    const bool even = (NT & 1) == 0;
    const bool need1 = 32 * wid + 31 >= (NT - 1) * KVBLK - cur.P0, need2 = 32 * wid + 31 >= (NT - 2) * KVBLK - cur.P0;
    if (even && need1) { SBAR(); qkt<1>(pB0, pB1, K_lds, r32, hi, S.qr); SBAR(); }
    SLOAD_H(nxt.K, nxt.V, 0); SBAR();
#pragma unroll
    for (int d0 = 0; d0 < 8; ++d0) S.qr[d0] = load8(nxt.Q + (size_t)(wid * QBLK + r32) * RS + d0 * 16 + hi * 8);
    SBAR();
    if (!even || need2) { finishSM(pA0, pA1, alA, l_reg, pa0, pa1, pa2, pa3); SBAR();
        pv_tile<0>(o, vb0, pa0, pa1, pa2, pa3); }
    if (even) { if (need1) { MASKT(pB0, pB1, NT - 1); partialSM(pB0, pB1, m_reg, mnB, alB); } __syncthreads();
        if (need1) { RESC(alB); finishSM(pB0, pB1, alB, l_reg, pa0, pa1, pa2, pa3); SBAR(); pv_tile<1>(o, vb0, pa0, pa1, pa2, pa3); } }
    SBAR(); SEAM_K0();
    if (hi == 0) li_l[r32] = l_reg; asm volatile("s_waitcnt lgkmcnt(0)" ::: "memory");
    float rli[16];
#pragma unroll
    for (int r = 0; r < 16; ++r) rli[r] = __builtin_amdgcn_rcpf(li_l[crow(r, hi)]);
    bf16_t* Ow = cur.O + (size_t)(wid * QBLK) * RS;
#pragma unroll
    for (int r = 0; r < 16; ++r) { const int orow = crow(r, hi);
#pragma unroll
        for (int d0 = 0; d0 < 4; ++d0) { const float v = o[d0][r] * rli[r];
            const float vn = __shfl_xor(v, 1);
            if ((r32 & 1) == 0) *(unsigned*)(Ow + (size_t)orow * RS + d0 * 32 + r32) = cvtpk(v, vn); } }
    __syncthreads();
#undef RESC
#undef KBASE
#undef MASKT
#undef SEAM_K0
#undef HALF_STEP
#undef QK_SM_SCHED
#undef SGB
}
#undef ROW
#undef VMW
#undef VMWN
#undef SLOAD_H
#undef SWRITE_HK
#undef SWRITE_HV
#undef SWRITE_H
#undef KSWZ
#undef SBAR
}

__device__ __forceinline__ att::BlockRef att_ref(Frame& F, int bh, int qb, size_t obase = WS_Q) {
    const int b = bh >> 3, h = bh & 7; att::BlockRef r;
    bf16_t* Qb = (bf16_t*)(F.ws + WS_Q); const bf16_t* Kb = (const bf16_t*)(F.ws + WS_K); const bf16_t* Vb = (const bf16_t*)(F.ws + WS_V);
    r.Q = Qb + ((size_t)b * SEQ + (size_t)qb * 256) * 1024 + h * 128; r.O = (bf16_t*)(F.ws + obase) + ((size_t)b * SEQ + (size_t)qb * 256) * 1024 + h * 128;
    r.K = Kb + (size_t)b * SEQ * 1024 + h * 128; r.V = Vb + (size_t)b * SEQ * 1024 + h * 128;
    r.MW = (const u64*)(F.ws + WS_MASK) + ((size_t)(b * 128 + qb * 8) * 64) * 32; r.P0 = qb * 256;
    return r;
}
__device__ __forceinline__ void p3_attn(const Args& A, Frame& F, size_t obase = WS_Q) {
    const int G = F.G; int L, stride, limit;
    if (G % 8 == 0) { L = (F.bx & 7) * 64 + (F.bx >> 3); stride = G >> 3; limit = (F.bx & 7) * 64 + 64; } else { L = F.bx; stride = G; limit = 512; }
    if (L >= limit) return;
    int pass = 0;
    att::BlockRef cur = att_ref(F, L >> 3, L & 7, obase);
    att::Seam S;
    att::prime(cur, (char*)F.lds, S);
    for (;;) {
        const bool more_pass = pass == 0, more_item = L + stride < limit, last = !more_pass && !more_item;
        int passn = pass + 1, Ln = L;
        if (!more_pass) { passn = 0; Ln = more_item ? L + stride : L; }
        const att::BlockRef nxt = last ? cur : att_ref(F, Ln >> 3, passn ? 15 - (Ln & 7) : (Ln & 7), obase);
        att::block(cur, nxt, (char*)F.lds, S);
        if (last) break;
        cur = nxt; pass = passn; L = Ln;
    }
}

struct SchedTwo {
    const char* A0; const char* B0; const char* A1; const char* B1; int nM, nN, G, c; size_t tstep;
    __device__ __forceinline__ bool next(int i, pg8::Seg& s) const {
        int pm, pn; if (!pg8::static_tile(i >> 1, G, c, nM, nN, pm, pn)) return false;
        s.pm = pm; s.pn = pn; s.aux = 0;
        if ((i & 1) == 0) { s.A = A0 + (size_t)pm * tstep; s.B = B0 + (size_t)pn * tstep; s.kind = 1; }
        else { s.A = A1 + (size_t)pm * tstep; s.B = B1 + (size_t)pn * tstep; s.kind = 2; }
        return true;
    }
    __device__ __forceinline__ int row(const pg8::Seg&, int) const { return 0; }
};
struct EpiMerge {
    static constexpr bool PERM = true; static constexpr int NST = 16;
    const bf16_t* sga; const bf16_t* sgb; bf16_t* mg;
    __device__ __forceinline__ void mid(f32x4 (&acc)[2][2][4][2], const pg8::Seg& u, int wr, int wc, int fr, int fq) const {
        const int row0 = u.pm * 256 + wr * 64 + fr, col0 = u.pn * 256 + wc * 32 + 8 * fq;
#pragma unroll
        for (int ai = 0; ai < 2; ++ai)
#pragma unroll
            for (int m = 0; m < 4; ++m)
#pragma unroll
                for (int bj = 0; bj < 2; ++bj) { const size_t off = (size_t)(row0 + ai * 128 + m * 16) * 1024 + col0 + bj * 128;
                    const u32x4 a = *(const u32x4*)(sga + off), b = *(const u32x4*)(sgb + off);
                    const unsigned aw[4] = {a.x, a.y, a.z, a.w}, bw[4] = {b.x, b.y, b.z, b.w};
#pragma unroll
                    for (int j = 0; j < 4; ++j) { const float r0 = bf_lo(aw[j]) * __builtin_amdgcn_rcpf(fmaxf(bf_lo(bw[j]), 1e-30f)), r1 = bf_hi(aw[j]) * __builtin_amdgcn_rcpf(fmaxf(bf_hi(bw[j]), 1e-30f));
                        acc[ai][bj][m][j >> 1][(j & 1) * 2] *= r0; acc[ai][bj][m][j >> 1][(j & 1) * 2 + 1] *= r1; } }
    }
    __device__ __forceinline__ void operator()(f32x4 (&acc)[2][2][4][2], const pg8::Seg& u, int wr, int wc, int fr, int fq) const {
        const int row0 = u.pm * 256 + wr * 64 + fr, col0 = u.pn * 256 + wc * 32 + 8 * fq;
#pragma unroll
        for (int ai = 0; ai < 2; ++ai) {
            u32x4 gb[4][2];
#pragma unroll
            for (int m = 0; m < 4; ++m)
#pragma unroll
                for (int bj = 0; bj < 2; ++bj) gb[m][bj] = *(const u32x4*)(sgb + (size_t)(row0 + ai * 128 + m * 16) * 1024 + col0 + bj * 128);
#pragma unroll
            for (int m = 0; m < 4; ++m)
#pragma unroll
                for (int bj = 0; bj < 2; ++bj) { const size_t off = (size_t)(row0 + ai * 128 + m * 16) * 1024 + col0 + bj * 128;
                    const u32x4 b = gb[m][bj]; const unsigned bw[4] = {b.x, b.y, b.z, b.w};
                    f32x4 v0 = acc[ai][bj][m][0], v1 = acc[ai][bj][m][1];
                    v0[0] *= fmaxf(bf_lo(bw[0]), 1e-30f); v0[1] *= fmaxf(bf_hi(bw[0]), 1e-30f); v0[2] *= fmaxf(bf_lo(bw[1]), 1e-30f); v0[3] *= fmaxf(bf_hi(bw[1]), 1e-30f);
                    v1[0] *= fmaxf(bf_lo(bw[2]), 1e-30f); v1[1] *= fmaxf(bf_hi(bw[2]), 1e-30f); v1[2] *= fmaxf(bf_lo(bw[3]), 1e-30f); v1[3] *= fmaxf(bf_hi(bw[3]), 1e-30f);
                    *(u32x4*)(mg + off) = pack8v(v0, v1); } }
    }
};
__device__ __forceinline__ void p4a_merge(const Args& A, Frame& F) {
    SchedTwo S; S.A0 = (const char*)(F.ws + WS_SU); S.B0 = (const char*)(F.ws + WS_WA); S.A1 = (const char*)(F.ws + WS_Q); S.B1 = (const char*)(F.ws + WS_WB);
    S.nM = T / 256; S.nN = D / 256; S.G = F.G; S.c = F.bx; S.tstep = (size_t)256 * D * 2;
    EpiMerge E; E.sga = (const bf16_t*)F.out; E.sgb = (const bf16_t*)((unsigned char*)F.out + 64 * MiB); E.mg = (bf16_t*)(F.ws + WS_MG);
    pg8::gemm_phase<EpiMerge, SchedTwo, false>(F.lds, S, E, D, D, D / 64);
}

struct EpiRes {
    static constexpr bool PERM = true; static constexpr int NST = 16;
    const float* x; bf16_t* h1;
    __device__ __forceinline__ void mid(f32x4 (&)[2][2][4][2], const pg8::Seg&, int, int, int, int) const {}
    __device__ __forceinline__ void operator()(f32x4 (&acc)[2][2][4][2], const pg8::Seg& u, int wr, int wc, int fr, int fq) const {
        const int row0 = u.pm * 256 + wr * 64 + fr, col0 = u.pn * 256 + wc * 32 + 8 * fq;
#pragma unroll
        for (int ai = 0; ai < 2; ++ai) {
            f32x4 xa[4][2][2];
#pragma unroll
            for (int m = 0; m < 4; ++m)
#pragma unroll
                for (int bj = 0; bj < 2; ++bj) { const size_t off = (size_t)(row0 + ai * 128 + m * 16) * 1024 + col0 + bj * 128; xa[m][bj][0] = *(const f32x4*)(x + off); xa[m][bj][1] = *(const f32x4*)(x + off + 4); }
#pragma unroll
            for (int m = 0; m < 4; ++m)
#pragma unroll
                for (int bj = 0; bj < 2; ++bj) { const size_t off = (size_t)(row0 + ai * 128 + m * 16) * 1024 + col0 + bj * 128;
                    *(u32x4*)(h1 + off) = pack8v(xa[m][bj][0] + acc[ai][bj][m][0], xa[m][bj][1] + acc[ai][bj][m][1]); } }
    }
};
__device__ __forceinline__ void p4b_out(const Args& A, Frame& F) {
    SchedDense S; S.A = (const char*)(F.ws + WS_MG); S.B = (const char*)(F.ws + WS_WO); S.nM = T / 256; S.nN = D / 256; S.G = F.G; S.c = F.bx; S.tstepA = (size_t)256 * D * 2; S.tstepB = (size_t)256 * D * 2;
    EpiRes E; E.x = ((const float*)A.in[0]); E.h1 = (bf16_t*)(F.ws + WS_H1);
    pg8::gemm_phase<EpiRes, SchedDense, false>(F.lds, S, E, D, D, D / 64);
}

constexpr int P5_WH = 0, P5_WP = 2064, P5_WL = 36 * P5_WP, P5_RT = 2 * 36 * P5_WP, P5_CNT = P5_RT + 2048, P5_LOG = 0, P5_WC = P5_CNT + 512, P5_G2 = P5_WC + 512;
__device__ __forceinline__ void convert_wein(const Args& A, Frame& F, int gw, int NGW) {
    __syncthreads();
    LAS float* scr = (LAS float*)(F.lds + F.wave * 16384); const int lane = F.lane;
    constexpr int I_IN = (D / 64) * (512 / 32), TOT = NEXP * I_IN;
    const float* g2 = (const float*)A.in[10];
#define WEIN_LOAD(R, it_) do { const int itc_ = (it_) < TOT ? (it_) : TOT - 1, e_ = itc_ / I_IN; titem_load<2>(R, ((const float*)A.in[15]) + (size_t)e_ * D * 512, 512, 512, itc_ % I_IN, lane, g2); } while (0)
#define WEIN_FIN(R, it_) do { const int e_ = (it_) / I_IN; titem_finish(R, D, 512, (bf16_t*)(F.ws + (e_ < 16 ? WS_WEIN_A : WS_WEIN_B)) + (size_t)(e_ & 15) * 512 * D, scr, (it_) % I_IN, lane); } while (0)
    if (gw < TOT) { TItemRegs Ra, Rb; int it = gw; WEIN_LOAD(Ra, it);
        for (;;) {
            WEIN_LOAD(Rb, it + NGW); __builtin_amdgcn_sched_barrier(0); WEIN_FIN(Ra, it); it += NGW; if (it >= TOT) break;
            WEIN_LOAD(Ra, it + NGW); __builtin_amdgcn_sched_barrier(0); WEIN_FIN(Rb, it); it += NGW; if (it >= TOT) break;
        } }
#undef WEIN_LOAD
#undef WEIN_FIN
    __syncthreads();
}
__device__ __forceinline__ void convert_sq(const Args& A, Frame& F, int gw, int NGW) {
    __syncthreads();
    LAS float* scr = (LAS float*)(F.lds + F.wave * 16384); const int lane = F.lane;
    constexpr int I_SQ = (D / 64) * (D / 32), TOT = 3 * I_SQ;
#define SQ_LOAD(R, it_) do { const int itc_ = (it_) < TOT ? (it_) : TOT - 1, m_ = itc_ / I_SQ; titem_load<0>(R, (const float*)A.in[7 + m_], D, D, itc_ % I_SQ, lane, nullptr); } while (0)
#define SQ_FIN(R, it_) do { const int m_ = (it_) / I_SQ; titem_finish(R, D, D, (bf16_t*)(F.ws + (m_ == 0 ? WS_WA : m_ == 1 ? WS_WB : WS_WO)), scr, (it_) % I_SQ, lane); } while (0)
    if (gw < TOT) { TItemRegs Ra, Rb; int it = gw; SQ_LOAD(Ra, it);
        for (;;) {
            SQ_LOAD(Rb, it + NGW); __builtin_amdgcn_sched_barrier(0); SQ_FIN(Ra, it); it += NGW; if (it >= TOT) break;
            SQ_LOAD(Ra, it + NGW); __builtin_amdgcn_sched_barrier(0); SQ_FIN(Rb, it); it += NGW; if (it >= TOT) break;
        } }
#undef SQ_LOAD
#undef SQ_FIN
    __syncthreads();
}
__device__ __forceinline__ void convert_weout(const Args& A, Frame& F, int gw, int NGW) {
    __syncthreads();
    LAS float* scr = (LAS float*)(F.lds + F.wave * 16384); const int lane = F.lane;
    bf16_t* WEO = (bf16_t*)(F.ws + WS_WEOUT);
    constexpr int I_OUT = (DEXP / 64) * (D / 32);
    for (int q = gw; q < NEXP * I_OUT; q += NGW) { const int e = q / I_OUT, r = q % I_OUT;
        transpose_item<0>(((const float*)A.in[16]) + (size_t)e * DEXP * D, DEXP, D, D, WEO + (size_t)e * D * DEXP, scr, r, lane); }
    __syncthreads();
}
__device__ __forceinline__ void p5_route(const Args& A, Frame& F) {
    LAS unsigned char* lds = F.lds; const int tid = F.tid, lane = F.lane, wave = F.wave;
    LAS int* RTe = (LAS int*)(lds + P5_RT); LAS float* RTg = (LAS float*)(lds + P5_RT + 1024); LAS int* LC = (LAS int*)(lds + P5_CNT); LAS int* WC = (LAS int*)(lds + P5_WC);
    unsigned* LIST = (unsigned*)(F.ws + WS_LIST); unsigned* ECNT = (unsigned*)(F.ws + WS_CTL) + CW_ECNT; float* GATEL = (float*)(F.ws + WS_GATEL); float* RSTDL = (float*)(F.ws + WS_RSTDL); LAS float* RSl = (LAS float*)(lds + P5_G2);
    for (int rb = F.bx; rb < T / 128; rb += F.G) {
        for (int i = tid; i < 72 * 128; i += 512) { const int c = i >> 7, off = (i & 127) * 16;
            const u32x4 v = *(const u32x4*)((const unsigned char*)(F.ws + WS_WRT) + (size_t)i * 16);
            *(LAS u32x4*)(lds + (c < 36 ? P5_WH + c * P5_WP : P5_WL + (c - 36) * P5_WP) + off) = v; }
        __syncthreads();
        const int lr = lane & 15, kq = lane >> 4; const size_t row = (size_t)rb * 128 + 16 * wave + lr;
        f32x4 acc[3]; acc[0] = (f32x4){0.f, 0.f, 0.f, 0.f}; acc[1] = acc[0]; acc[2] = acc[0]; float ss = 0.f;
#ifdef P5_DUP_ROWS
        for (int rep = 0; rep < 2; ++rep)
#endif
        {
        const bf16_t* hrow = (const bf16_t*)(F.ws + WS_H1) + row * D + 8 * kq;
        const int n2 = (32 + lr) > 35 ? 35 : (32 + lr);
        const LAS unsigned char* bh0 = lds + P5_WH + lr * P5_WP + 16 * kq; const LAS unsigned char* bh1 = bh0 + 16 * P5_WP; const LAS unsigned char* bh2 = lds + P5_WH + n2 * P5_WP + 16 * kq;
#pragma unroll 1
        for (int hf = 0; hf < 2; ++hf) {
            u32x4 hq[16];
#pragma unroll
            for (int i = 0; i < 16; ++i) hq[i] = *(const u32x4*)(hrow + 32 * (16 * hf + i));
#pragma unroll
            for (int i = 0; i < 16; ++i) { const int ks = 16 * hf + i; const u32x4 hw = hq[i];
                const f32x4 h0 = {bf_lo(hw.x), bf_hi(hw.x), bf_lo(hw.y), bf_hi(hw.y)}, h1 = {bf_lo(hw.z), bf_hi(hw.z), bf_lo(hw.w), bf_hi(hw.w)};
                ss += (h0.x * h0.x + h0.y * h0.y) + (h0.z * h0.z + h0.w * h0.w) + (h1.x * h1.x + h1.y * h1.y) + (h1.z * h1.z + h1.w * h1.w);
                const bf16x8 ahi = __builtin_bit_cast(bf16x8, hw);
                { const bf16x8 wh = *(const LAS bf16x8*)(bh0 + 64 * ks), wl = *(const LAS bf16x8*)(bh0 + 64 * ks + P5_WL);
                  acc[0] = __builtin_amdgcn_mfma_f32_16x16x32_bf16(ahi, wh, acc[0], 0, 0, 0); acc[0] = __builtin_amdgcn_mfma_f32_16x16x32_bf16(ahi, wl, acc[0], 0, 0, 0); }
                { const bf16x8 wh = *(const LAS bf16x8*)(bh1 + 64 * ks), wl = *(const LAS bf16x8*)(bh1 + 64 * ks + P5_WL);
                  acc[1] = __builtin_amdgcn_mfma_f32_16x16x32_bf16(ahi, wh, acc[1], 0, 0, 0); acc[1] = __builtin_amdgcn_mfma_f32_16x16x32_bf16(ahi, wl, acc[1], 0, 0, 0); }
                { const bf16x8 wh = *(const LAS bf16x8*)(bh2 + 64 * ks), wl = *(const LAS bf16x8*)(bh2 + 64 * ks + P5_WL);
                  acc[2] = __builtin_amdgcn_mfma_f32_16x16x32_bf16(ahi, wh, acc[2], 0, 0, 0); acc[2] = __builtin_amdgcn_mfma_f32_16x16x32_bf16(ahi, wl, acc[2], 0, 0, 0); }
            }
        }
        }
#ifdef P5_DUP_ROWS
        ss *= 0.5f; acc[0] = acc[0] * 0.5f; acc[1] = acc[1] * 0.5f; acc[2] = acc[2] * 0.5f;
#endif
        ss += __shfl_xor(ss, 16); ss += __shfl_xor(ss, 32);
        const float rstd = 1.0f / sqrtf(ss * (1.f / D) + EPS);
        __syncthreads();
        LAS float* LOG = (LAS float*)(lds + P5_LOG) + wave * (16 * 48);
#pragma unroll
        for (int ct = 0; ct < 3; ++ct)
#pragma unroll
            for (int r = 0; r < 4; ++r) LOG[(4 * kq + r) * 48 + 16 * ct + lr] = acc[ct][r];
        LDS_WAIT();
        if (lane < 16) {
            float lg[36];
#pragma unroll
            for (int c = 0; c < 36; c += 4) { const f32x4 t = *(const LAS f32x4*)(LOG + lane * 48 + c); lg[c] = t.x; lg[c + 1] = t.y; lg[c + 2] = t.z; lg[c + 3] = t.w; }
#pragma unroll
            for (int c = 0; c < 36; ++c) lg[c] = lg[c] * rstd + ((c < 4) ? ((const float*)A.in[12])[c] : ((const float*)A.in[14])[c - 4]);
            int gs = 0; float gm = lg[0];
#pragma unroll
            for (int c = 1; c < 4; ++c) if (lg[c] > gm) { gm = lg[c]; gs = c; }
            float den = 0.f;
#pragma unroll
            for (int c = 0; c < 4; ++c) den += __expf(lg[c] - gm);
            const float gprob = 1.0f / den;
            float el[8];
#pragma unroll
            for (int i = 0; i < 8; ++i) { el[i] = lg[4 + i];
#pragma unroll
                for (int g = 1; g < 4; ++g) el[i] = (gs == g) ? lg[4 + 8 * g + i] : el[i]; }
            int i1 = 0; float v1 = el[0];
#pragma unroll
            for (int i = 1; i < 8; ++i) if (el[i] > v1) { v1 = el[i]; i1 = i; }
            int i2 = -1; float v2 = -__builtin_inff();
#pragma unroll
            for (int i = 0; i < 8; ++i) if (i != i1 && (i2 < 0 || el[i] > v2)) { v2 = el[i]; i2 = i; }
            const float p2 = 1.0f / (1.0f + __expf(v1 - v2)), p1 = 1.0f - p2; const int lrow = 16 * wave + lane;
            RTe[2 * lrow] = gs * 8 + i1; RTe[2 * lrow + 1] = gs * 8 + i2; RTg[2 * lrow] = gprob * p1; RTg[2 * lrow + 1] = gprob * p2; RSl[lrow] = rstd;
        }
        __syncthreads();
        int e = 0, rank = 0;
        if (tid < 256) { e = RTe[tid];
            for (int ee = 0; ee < 32; ++ee) { const u64 m = __ballot(e == ee); if (lane == 0) WC[wave * 32 + ee] = __builtin_popcountll(m);
                if (e == ee) rank = (int)__builtin_amdgcn_mbcnt_hi((unsigned)(m >> 32), __builtin_amdgcn_mbcnt_lo((unsigned)m, 0u)); } }
        __syncthreads();
        if (tid < 32) { const int c = WC[tid] + WC[32 + tid] + WC[64 + tid] + WC[96 + tid];
            LC[tid] = c ? (int)__hip_atomic_fetch_add(ECNT + tid, (unsigned)c, __ATOMIC_RELAXED, __HIP_MEMORY_SCOPE_AGENT) : 0; }
        __syncthreads();
        if (tid < 256) { int lo = LC[e];
            for (int w = 0; w < 4; ++w) lo += (w < wave) ? WC[w * 32 + e] : 0;
            const unsigned ts = (unsigned)(rb * 128 + (tid >> 1)) * 2u + (tid & 1);
            const size_t at = (size_t)e * T + lo + rank; LIST[at] = ts; GATEL[at] = RTg[tid]; RSTDL[at] = RSl[tid >> 1]; }
        __syncthreads();
    }
}
constexpr int P6_TAB = 131072;
struct SchedMoe1 {
    const LAS int* tab; const char* xn2; const char* wein; const char* wein2; const unsigned* list; int G, c;
    __device__ __forceinline__ bool next(int i, pg8::Seg& s) const {
        const int ntot = tab[32]; long u;
        if ((G & 7) == 0) { const long U = 2L * ntot, per = (U + 7) >> 3, off = (long)i * (G >> 3) + (c >> 3); u = (c & 7) * per + off; if (off >= per || u >= U) return false; }
        else { u = (long)i * G + c; if (u >= 2L * ntot) return false; }
        const int gt = (int)(u >> 1), pn = (int)(u & 1); int e = 0;
        for (int k = 1; k < 32; ++k) e += (tab[k] <= gt) ? 1 : 0;
        s.pm = gt; s.pn = pn; s.aux = (e << 16) | (gt - tab[e]); s.kind = 3; s.A = xn2; s.B = (e < 16 ? wein : wein2) + ((size_t)(e & 15) * 512 + pn * 256) * D * 2; return true;
    }
    __device__ __forceinline__ int row(const pg8::Seg& s, int R) const {
        const int e = s.aux >> 16, idx = (s.aux & 0xffff) * 256 + R; const int cnt = tab[33 + e];
        const unsigned v = list[(size_t)e * T + (idx < cnt ? idx : 0)];
        return idx < cnt ? (int)(v >> 1) : 0;
    }
};
struct EpiAct {
    static constexpr bool PERM = true; static constexpr int NST = 16;
    bf16_t* act; const LAS int* tab; const unsigned* list; const float* rstd;
    __device__ __forceinline__ void mid(f32x4 (&)[2][2][4][2], const pg8::Seg&, int, int, int, int) const {}
    __device__ __forceinline__ void operator()(f32x4 (&acc)[2][2][4][2], const pg8::Seg& u, int wr, int wc, int fr, int fq) const {
        const int row0 = u.pm * 256 + wr * 64 + fr, col0 = u.pn * 128 + wc * 32 + 8 * fq;
        float rsv[2][4];
#pragma unroll
        for (int ai = 0; ai < 2; ++ai)
#pragma unroll
            for (int m = 0; m < 4; ++m) { const int e = u.aux >> 16, idx = (u.aux & 0xffff) * 256 + ai * 128 + wr * 64 + m * 16 + fr; const bool ok = idx < tab[33 + e]; const float v = rstd[(size_t)e * T + (ok ? idx : 0)]; rsv[ai][m] = ok ? v : 0.f; }
#pragma unroll
        for (int ai = 0; ai < 2; ++ai)
#pragma unroll
            for (int m = 0; m < 4; ++m) { f32x4 o0, o1;
                const float rs = rsv[ai][m];
#pragma unroll
                for (int j = 0; j < 4; ++j) { const float g0 = acc[ai][0][m][0][j] * rs, g1 = acc[ai][0][m][1][j] * rs;
                    o0[j] = g0 * fast_sigmoid(g0) * (acc[ai][1][m][0][j] * rs); o1[j] = g1 * fast_sigmoid(g1) * (acc[ai][1][m][1][j] * rs); }
                *(u32x4*)(act + (size_t)(row0 + ai * 128 + m * 16) * DEXP + col0) = pack8v(o0, o1); }
    }
};
struct SchedMoe2 {
    const LAS int* tab; const char* act; const char* weout; int G, c;
    __device__ __forceinline__ bool next(int i, pg8::Seg& s) const {
        const int ntot = tab[32]; long u;
        if ((G & 7) == 0) { const long U = 4L * ntot, per = (U + 7) >> 3, off = (long)i * (G >> 3) + (c >> 3); u = (c & 7) * per + off; if (off >= per || u >= U) return false; }
        else { u = (long)i * G + c; if (u >= 4L * ntot) return false; }
        const int gt = (int)(u >> 2), pn = (int)(u & 3); int e = 0;
        for (int k = 1; k < 32; ++k) e += (tab[k] <= gt) ? 1 : 0;
        s.pm = gt; s.pn = pn; s.aux = (e << 16) | (gt - tab[e]); s.kind = 3; s.A = act + (size_t)gt * 256 * DEXP * 2; s.B = weout + ((size_t)e * D + pn * 256) * DEXP * 2; return true;
    }
    __device__ __forceinline__ int row(const pg8::Seg&, int) const { return 0; }
};
struct EpiMoeOut {
    static constexpr bool PERM = true; static constexpr int NST = 16;
    const LAS int* tab; const unsigned* list; const float* gate; bf16_t* ym; bf16_t* dump;
    __device__ __forceinline__ void mid(f32x4 (&)[2][2][4][2], const pg8::Seg&, int, int, int, int) const {}
    __device__ __forceinline__ void operator()(f32x4 (&acc)[2][2][4][2], const pg8::Seg& u, int wr, int wc, int fr, int fq) const {
        const int e = u.aux >> 16, rtl = u.aux & 0xffff, cnt = tab[33 + e], col0 = u.pn * 256 + wc * 32 + 8 * fq;
        unsigned tsv[2][4]; float gv[2][4];
#pragma unroll
        for (int ai = 0; ai < 2; ++ai)
#pragma unroll
            for (int m = 0; m < 4; ++m) { const int idx = rtl * 256 + ai * 128 + wr * 64 + m * 16 + fr; const bool ok = idx < cnt; const size_t at = (size_t)e * T + (ok ? idx : 0);
                tsv[ai][m] = list[at]; gv[ai][m] = gate[at]; }
#pragma unroll
        for (int ai = 0; ai < 2; ++ai)
#pragma unroll
            for (int m = 0; m < 4; ++m) { const int idx = rtl * 256 + ai * 128 + wr * 64 + m * 16 + fr;
                const float g = gv[ai][m]; bf16_t* dst = (idx < cnt) ? ym + (size_t)tsv[ai][m] * D : dump + (size_t)(idx & 255) * D;
#pragma unroll
                for (int bj = 0; bj < 2; ++bj) *(u32x4*)(dst + col0 + bj * 128) = pack8v(acc[ai][bj][m][0] * g, acc[ai][bj][m][1] * g); }
    }
};
__device__ __forceinline__ void p6_tables(const Args& A, Frame& F) {
    LAS int* tab = (LAS int*)(F.lds + P6_TAB);
    if (F.tid < 64) {
        const unsigned* ECNT = (const unsigned*)(F.ws + WS_CTL) + CW_ECNT;
        const int c = (F.tid < 32) ? (int)__hip_atomic_load(ECNT + F.tid, __ATOMIC_RELAXED, __HIP_MEMORY_SCOPE_AGENT) : 0;
        const int tiles = (c + 255) >> 8; int incl = tiles;
#pragma unroll
        for (int d = 1; d < 32; d <<= 1) { const int t = __shfl_up(incl, d); if (F.lane >= d) incl += t; }
        if (F.tid < 32) { tab[F.tid] = incl - tiles; tab[33 + F.tid] = c; if (F.tid == 31) tab[32] = incl; } }
    __syncthreads();
}
__device__ __forceinline__ void p6a_moe_in(const Args& A, Frame& F) {
    p6_tables(A, F);
    SchedMoe1 S; S.tab = (const LAS int*)(F.lds + P6_TAB); S.xn2 = (const char*)(F.ws + WS_H1); S.wein = (const char*)(F.ws + WS_WEIN_A); S.wein2 = (const char*)(F.ws + WS_WEIN_B); S.list = (const unsigned*)(F.ws + WS_LIST); S.G = F.G; S.c = F.bx;
    EpiAct E; E.act = (bf16_t*)(F.ws + WS_ACT); E.tab = S.tab; E.list = S.list; E.rstd = (const float*)(F.ws + WS_RSTDL);
    pg8::gemm_phase<EpiAct, SchedMoe1, true>(F.lds, S, E, D, D, D / 64);
    { const int ntot = S.tab[32]; int rank = F.bx, nconv = F.G;
      if ((F.G & 7) == 0) { const int per = (2 * ntot + 7) >> 3, g8 = F.G >> 3, jf = per % g8, j = F.bx >> 3; rank = (F.bx & 7) * (g8 - jf) + (j - jf); nconv = (j >= jf) ? 8 * (g8 - jf) : 0; }
      if (nconv > 0) { asm volatile("s_waitcnt vmcnt(0)" ::: "memory"); convert_weout(A, F, rank * NWAVES + F.wave, nconv * NWAVES); } }
}
__device__ __forceinline__ void p6b_moe_out(const Args& A, Frame& F) {
    p6_tables(A, F);
    SchedMoe2 S; S.tab = (const LAS int*)(F.lds + P6_TAB); S.act = (const char*)(F.ws + WS_ACT); S.weout = (const char*)(F.ws + WS_WEOUT); S.G = F.G; S.c = F.bx;
    EpiMoeOut E; E.tab = S.tab; E.list = (const unsigned*)(F.ws + WS_LIST); E.gate = (const float*)(F.ws + WS_GATEL); E.dump = (bf16_t*)(F.ws + WS_V + 48 * MiB); E.ym = (bf16_t*)(F.ws + WS_YM);
    int nt = DEXP / 64; asm volatile("" : "+s"(nt));
    pg8::gemm_phase<EpiMoeOut, SchedMoe2, false>(F.lds, S, E, DEXP, DEXP, nt);
}

__device__ __forceinline__ void p7_final(const Args& A, Frame& F) {
    const int gw = F.bx * NWAVES + F.wave, NGW = F.G * NWAVES, lane = F.lane; const bf16_t* YM = (const bf16_t*)(F.ws + WS_YM);
    f32x4 gq[4];
#pragma unroll
    for (int j = 0; j < 4; ++j) gq[j] = ((const f32x4*)((const float*)A.in[17]) + lane)[64 * j];
    for (int m0 = gw; m0 < T; m0 += 2 * NGW) {
        const int m1 = (m0 + NGW < T) ? m0 + NGW : m0;
        f32x4* hp0 = (f32x4*)(F.out + (size_t)m0 * D) + lane; f32x4* hp1 = (f32x4*)(F.out + (size_t)m1 * D) + lane;
        const u32x2* hb0 = (const u32x2*)((const bf16_t*)(F.ws + WS_H1) + (size_t)m0 * D) + lane; const u32x2* hb1 = (const u32x2*)((const bf16_t*)(F.ws + WS_H1) + (size_t)m1 * D) + lane;
        const u32x2* ya0 = (const u32x2*)(YM + (size_t)(2 * m0) * D) + lane; const u32x2* yb0 = (const u32x2*)(YM + (size_t)(2 * m0 + 1) * D) + lane;
        const u32x2* ya1 = (const u32x2*)(YM + (size_t)(2 * m1) * D) + lane; const u32x2* yb1 = (const u32x2*)(YM + (size_t)(2 * m1 + 1) * D) + lane;
        f32x4 v0[4], v1[4]; u32x2 a0[4], b0[4], a1[4], b1[4], c0[4], c1[4];
#pragma unroll
        for (int j = 0; j < 4; ++j) { c0[j] = hb0[64 * j]; a0[j] = ya0[64 * j]; b0[j] = yb0[64 * j]; c1[j] = hb1[64 * j]; a1[j] = ya1[64 * j]; b1[j] = yb1[64 * j]; }
#pragma unroll
        for (int j = 0; j < 4; ++j) { v0[j] = (f32x4){bf_lo(c0[j].x), bf_hi(c0[j].x), bf_lo(c0[j].y), bf_hi(c0[j].y)}; v1[j] = (f32x4){bf_lo(c1[j].x), bf_hi(c1[j].x), bf_lo(c1[j].y), bf_hi(c1[j].y)}; }
        float s0 = 0.f, s1 = 0.f;
#pragma unroll
        for (int j = 0; j < 4; ++j) {
            v0[j].x += bf_lo(a0[j].x) + bf_lo(b0[j].x); v0[j].y += bf_hi(a0[j].x) + bf_hi(b0[j].x); v0[j].z += bf_lo(a0[j].y) + bf_lo(b0[j].y); v0[j].w += bf_hi(a0[j].y) + bf_hi(b0[j].y);
            v1[j].x += bf_lo(a1[j].x) + bf_lo(b1[j].x); v1[j].y += bf_hi(a1[j].x) + bf_hi(b1[j].x); v1[j].z += bf_lo(a1[j].y) + bf_lo(b1[j].y); v1[j].w += bf_hi(a1[j].y) + bf_hi(b1[j].y);
            s0 += (v0[j].x * v0[j].x + v0[j].y * v0[j].y) + (v0[j].z * v0[j].z + v0[j].w * v0[j].w); s1 += (v1[j].x * v1[j].x + v1[j].y * v1[j].y) + (v1[j].z * v1[j].z + v1[j].w * v1[j].w); }
        const float r0 = 1.0f / sqrtf(wave_sum(s0) * (1.f / D) + EPS), r1 = 1.0f / sqrtf(wave_sum(s1) * (1.f / D) + EPS);
#pragma unroll
        for (int j = 0; j < 4; ++j) { const f32x4 g = gq[j]; hp0[64 * j] = v0[j] * r0 * g; if (m1 != m0) hp1[64 * j] = v1[j] * r1 * g; }
    }
}

constexpr int N_PHASES = 11;
__global__ void __launch_bounds__(NWAVES * 64, 2) mega_fwd(Args A) {
    extern __shared__ __attribute__((aligned(16))) unsigned char lds_raw[];
    Frame F;
    F.lds = (LAS unsigned char*)lds_raw; F.tid = threadIdx.x; F.lane = F.tid & 63; F.wave = __builtin_amdgcn_readfirstlane(F.tid >> 6); F.G = gridDim.x; F.bx = blockIdx.x;
    F.out = A.out; F.ws = A.ws;
    volatile LAS unsigned* MISC = (volatile LAS unsigned*)(F.lds + MISC_OFF);
    if (F.tid < 64) MISC[F.tid] = 0u;
    __builtin_amdgcn_fence(__ATOMIC_ACQUIRE, "agent");
    asm volatile("s_waitcnt vmcnt(0) lgkmcnt(0)" ::: "memory");
    __syncthreads();
    const int lo = A.ph_lo, hi = A.ph_hi;
    XcdBarrier bar; bar.bar = (unsigned*)(F.ws + WS_CTL) + CW_BAR; bar.x = 0; bar.st = MISC + 8;
    if (hi - lo > 1) bar = xcd_barrier_post((unsigned*)(F.ws + WS_CTL) + CW_BAR, MISC + 8);
#ifndef PH_MASK
#define PH_MASK 0x7ff
#endif
#define IN(k) (((PH_MASK >> (k)) & 1) && lo <= (k) && (k) < hi)
#define SEAM(k) do { if (IN(k) && IN((k) + 1)) xcd_barrier(bar); } while (0)
#ifndef DUP_MASK
#define DUP_MASK 0
#endif
#define DUP(k) ((DUP_MASK >> (k)) & 1)
    if (IN(0)) { if (DUP(0)) { p0_prep(A, F); xcd_barrier(bar); } p0_prep(A, F); SEAM(0); }
    if (IN(1)) { if (DUP(1)) { p1_proj(A, F); xcd_barrier(bar); } p1_proj(A, F); SEAM(1); }
    if (IN(2)) {
        if (DUP(2)) { p2a_index(A, F); xcd_barrier(bar); }
        p2_both(A, F);
        SEAM(2); }
    if (IN(3)) {
#ifdef DUP_P3
        p3_attn(A, F, WS_XN1); xcd_barrier(bar);
#endif
        p3_attn(A, F); SEAM(3); }
    if (IN(4)) { if (DUP(4)) { p4a_merge(A, F); xcd_barrier(bar); } p4a_merge(A, F); SEAM(4); }
    if (IN(5)) { if (DUP(5)) { p4b_out(A, F); xcd_barrier(bar); } p4b_out(A, F); SEAM(5); }
    if (IN(6)) { if (DUP(6)) { p5_route(A, F); xcd_barrier(bar); } p5_route(A, F); SEAM(6); }
    if (IN(8)) { if (DUP(8)) { p6a_moe_in(A, F); xcd_barrier(bar); } p6a_moe_in(A, F); SEAM(8); }
    if (IN(9)) { if (DUP(9)) { p6b_moe_out(A, F); xcd_barrier(bar); } p6b_moe_out(A, F); SEAM(9); }
    if (IN(10)) { p7_final(A, F); }
    asm volatile("s_waitcnt vmcnt(0)" ::: "memory"); __syncthreads();
    if (F.tid == 0) { __builtin_amdgcn_fence(__ATOMIC_RELEASE, "agent"); asm volatile("s_waitcnt vmcnt(0)" ::: "memory"); }
#undef IN
#undef SEAM
}

#ifndef MK_N_LAUNCHES
#define MK_N_LAUNCHES 1
#endif
extern "C" void kernel_launch(void* const* d_in, const int* in_sizes, int n_in, void* d_out, int out_size, void* d_ws, size_t ws_size, hipStream_t stream) {
    static int grid = 0;
    if (grid == 0) {
        if (n_in != 18 || in_sizes[0] != T * D || out_size != T * D || ws_size < WS_TOTAL) {
            fprintf(stderr, "kernel_launch: unexpected problem (n_in %d, in0 %d, out %d, ws %zu; need ws >= %zu)\n", n_in, n_in > 0 ? in_sizes[0] : -1, out_size, ws_size, (size_t)WS_TOTAL); grid = -1; return; }
        int dev = 0, cus = 0, per_cu = 0;
        if (hipGetDevice(&dev) != hipSuccess || hipDeviceGetAttribute(&cus, hipDeviceAttributeMultiprocessorCount, dev) != hipSuccess) { grid = -1; return; }
        if (hipFuncSetAttribute((const void*)mega_fwd, hipFuncAttributeMaxDynamicSharedMemorySize, LDS_BYTES) != hipSuccess) { fprintf(stderr, "kernel_launch: hipFuncSetAttribute failed\n"); grid = -1; return; }
        if (hipOccupancyMaxActiveBlocksPerMultiprocessor(&per_cu, (const void*)mega_fwd, NWAVES * 64, LDS_BYTES) != hipSuccess || per_cu < 1) { fprintf(stderr, "kernel_launch: occupancy query says %d blocks per CU\n", per_cu); per_cu = 1; }
        (void)hipGetLastError();
        grid = cus;
    }
    if (grid < 0) return;
    (void)hipMemsetAsync((char*)d_ws + WS_CTL, 0, CTL_ZERO_BYTES, stream);
    Args a{};
    for (int i = 0; i < 18; ++i) a.in[i] = d_in[i];
    a.out = (float*)d_out; a.ws = (unsigned char*)d_ws;
    if (MK_N_LAUNCHES == 1) { a.ph_lo = 0; a.ph_hi = N_PHASES; hipLaunchKernelGGL(mega_fwd, dim3(grid), dim3(NWAVES * 64), LDS_BYTES, stream, a); }
    else for (int p = 0; p < N_PHASES; ++p) { a.ph_lo = p; a.ph_hi = p + 1; hipLaunchKernelGGL(mega_fwd, dim3(grid), dim3(NWAVES * 64), LDS_BYTES, stream, a); }
}
```
